# Optimizing an MI355X kernel written in HIP

```python
import jax
import jax.numpy as jnp
from jax import lax
import numpy as np

D_MODEL = 2048
BATCH = 4
SEQ = 4096
DEPTH = 4

GRID_W = 64
CTX_LEN = 256
NORM_EPS = 1e-6
NEG_INF = -1e30
N_MOD = 6

NA_HEADS = 8
NA_HEAD_DIM = 128
NA_WIDTH = NA_HEADS * NA_HEAD_DIM
NA_WIN_H = 8
NA_WIN_W = 16

LRU_WIDTH = 1024
LRU_BLOCKS = 8
LRU_BLOCK_DIM = LRU_WIDTH // LRU_BLOCKS
LRU_CONV_W = 4
LRU_C = 8.0

MLA_HEADS = 8
MLA_Q_RANK = 512
MLA_KV_RANK = 256
MLA_NOPE_DIM = 128
MLA_ROPE_DIM = 64
MLA_V_DIM = 128
MLA_QK_DIM = MLA_NOPE_DIM + MLA_ROPE_DIM
MLA_WIDTH = MLA_HEADS * MLA_V_DIM
ROPE_THETA = 10000.0
Q_BLOCK = 128

N_BRANCH = 3
BRANCH_WIDTH = 1024
D_IN = 3 * NA_WIDTH + 2 * LRU_WIDTH + MLA_Q_RANK + MLA_KV_RANK + MLA_ROPE_DIM + N_BRANCH * D_MODEL

D_FF = 5632
FFN_CONV_W = 3

kernel_name = 'hybrid_natten_rglru_mla_prefix_dit_block'


def rmsnorm(x, g):
    xf = x.astype(jnp.float32)
    y = xf * lax.rsqrt(jnp.mean(xf * xf, axis=-1, keepdims=True) + NORM_EPS)
    return (y * g.astype(jnp.float32)).astype(x.dtype)


def modulate(h, shift, scale):
    return h * (1 + scale) + shift


def depthwise_conv(x, w, b):
    width = w.shape[0]
    n = x.shape[1]
    pad_left = width // 2
    xp = jnp.pad(x, ((0, 0), (pad_left, width - 1 - pad_left), (0, 0)))
    return sum(xp[:, i:i + n] * w[i] for i in range(width)) + b


def axial_rope_angles(n_tok, dim):
    t = jnp.arange(n_tok, dtype=jnp.int32)
    row = (t // GRID_W).astype(jnp.float32)
    col = (t % GRID_W).astype(jnp.float32)
    n_freq = dim // 4
    inv_freq = ROPE_THETA ** (-jnp.arange(n_freq, dtype=jnp.float32) / n_freq)
    ang = jnp.concatenate([row[:, None] * inv_freq, col[:, None] * inv_freq], axis=-1)
    return jnp.cos(ang), jnp.sin(ang)


def apply_rope(x, cos, sin):
    half = x.shape[-1] // 2
    xf = x.astype(jnp.float32)
    x1, x2 = xf[..., :half], xf[..., half:]
    return jnp.concatenate([x1 * cos - x2 * sin, x1 * sin + x2 * cos], axis=-1).astype(x.dtype)


def split_in_proj(z):
    sizes = (3 * NA_WIDTH, LRU_WIDTH, LRU_WIDTH, MLA_Q_RANK, MLA_KV_RANK, MLA_ROPE_DIM)
    offsets = [int(o) for o in np.cumsum(sizes)]
    return jnp.split(z, offsets, axis=-1)


def softmax_attention(q, k, v):
    scale = q.shape[-1] ** -0.5
    s = jnp.einsum('bqhd,bkhd->bhqk', q, k).astype(jnp.float32) * scale
    p = jax.nn.softmax(s, axis=-1).astype(v.dtype)
    o = jnp.einsum('bhqk,bkhd->bqhd', p, v)
    return o.reshape(o.shape[0], o.shape[1], -1)


def neighbourhood_attention(q, k, v, k_ctx, v_ctx, rpb):
    bsz, n, heads, hd = q.shape
    rows = n // GRID_W
    kh = min(NA_WIN_H, rows)
    r = np.arange(rows)
    key_rows = np.clip(r - kh // 2, 0, rows - kh)[:, None] + np.arange(kh)[None, :]
    row_idx = key_rows - r[:, None] + (NA_WIN_H - 1)
    cidx = np.arange(GRID_W)
    c_start = np.clip(cidx - NA_WIN_W // 2, 0, GRID_W - NA_WIN_W)
    in_win = (cidx[None, :] >= c_start[:, None]) & (cidx[None, :] < c_start[:, None] + NA_WIN_W)
    col_idx = np.clip(cidx[None, :] - cidx[:, None], -(NA_WIN_W - 1), NA_WIN_W - 1) + (NA_WIN_W - 1)
    bias = rpb.astype(jnp.float32)[:, row_idx][..., col_idx]
    bias = jnp.where(in_win[None, None, :, None, :], bias.transpose(0, 1, 3, 2, 4), NEG_INF)
    scale = hd ** -0.5
    qg = q.reshape(bsz, rows, GRID_W, heads, hd)
    kg = jnp.take(k.reshape(bsz, rows, GRID_W, heads, hd), key_rows, axis=1)
    vg = jnp.take(v.reshape(bsz, rows, GRID_W, heads, hd), key_rows, axis=1)
    s_win = jnp.einsum('brqhd,brjkhd->bhrqjk', qg, kg).astype(jnp.float32) * scale + bias
    s_ctx = jnp.einsum('brqhd,blhd->bhrql', qg, k_ctx).astype(jnp.float32) * scale
    n_win = kh * GRID_W
    s = jnp.concatenate([s_win.reshape(bsz, heads, rows, GRID_W, n_win), s_ctx], axis=-1)
    p = jax.nn.softmax(s, axis=-1).astype(v.dtype)
    p_win = p[..., :n_win].reshape(bsz, heads, rows, GRID_W, kh, GRID_W)
    o = jnp.einsum('bhrqjk,brjkhd->brqhd', p_win, vg) + jnp.einsum('bhrql,blhd->brqhd', p[..., n_win:], v_ctx)
    return o.reshape(bsz, n, heads * hd)


def rglru_coeffs(x, w_a, b_a, w_x, b_x, lam):
    bsz, n, _ = x.shape
    xb = x.reshape(bsz, n, LRU_BLOCKS, LRU_BLOCK_DIM)
    gate_a = jnp.einsum('bnkc,kcd->bnkd', xb, w_a).reshape(bsz, n, LRU_WIDTH) + b_a
    gate_x = jnp.einsum('bnkc,kcd->bnkd', xb, w_x).reshape(bsz, n, LRU_WIDTH) + b_x
    r = jax.nn.sigmoid(gate_a.astype(jnp.float32))
    i = jax.nn.sigmoid(gate_x.astype(jnp.float32))
    log_a = -LRU_C * r * jax.nn.softplus(-lam.astype(jnp.float32))
    a = jnp.exp(log_a)
    b = jnp.sqrt(-jnp.expm1(2.0 * log_a)) * (i * x.astype(jnp.float32))
    return a, b


def _combine(e1, e2):
    a1, b1 = e1
    a2, b2 = e2
    return a1 * a2, a2 * b1 + b2


def linear_recurrence(a, b, h0):
    b = b.at[:, 0].add(a[:, 0] * h0)
    _, h = lax.associative_scan(_combine, (a, b), axis=1)
    return h


def bidirectional_rglru(u, u_c, w_a, b_a, w_x, b_x, lam):
    h0 = jnp.zeros((u_c.shape[0], LRU_WIDTH), jnp.float32)
    a_c, b_c = rglru_coeffs(u_c, w_a[0], b_a[0], w_x[0], b_x[0], lam[0])
    a_l, b_l = rglru_coeffs(u, w_a[0], b_a[0], w_x[0], b_x[0], lam[0])
    h_cf = linear_recurrence(a_c, b_c, h0)
    h_lf = linear_recurrence(a_l, b_l, h_cf[:, -1])
    a_c, b_c = rglru_coeffs(jnp.flip(u_c, 1), w_a[1], b_a[1], w_x[1], b_x[1], lam[1])
    a_l, b_l = rglru_coeffs(jnp.flip(u, 1), w_a[1], b_a[1], w_x[1], b_x[1], lam[1])
    h_cb = linear_recurrence(a_c, b_c, h0)
    h_lb = linear_recurrence(a_l, b_l, h_cb[:, -1])
    y = (h_lf + jnp.flip(h_lb, 1)).astype(u.dtype)
    return y, h_cf, jnp.flip(h_cb, 1)


def mla_queries(cq, q_norm, w_q_up, cos, sin):
    bsz, n, _ = cq.shape
    q = (rmsnorm(cq, q_norm) @ w_q_up).reshape(bsz, n, MLA_HEADS, MLA_QK_DIM)
    q_nope, q_rope = q[..., :MLA_NOPE_DIM], q[..., MLA_NOPE_DIM:]
    if cos is not None:
        q_rope = apply_rope(q_rope, cos[:, None, :], sin[:, None, :])
    return jnp.concatenate([q_nope, q_rope], axis=-1)


def mla_keys_values(ckv, k_rope, kv_norm, w_kv_up, cos, sin):
    bsz, n, _ = ckv.shape
    kv = (rmsnorm(ckv, kv_norm) @ w_kv_up).reshape(bsz, n, MLA_HEADS, MLA_NOPE_DIM + MLA_V_DIM)
    k_nope, v = kv[..., :MLA_NOPE_DIM], kv[..., MLA_NOPE_DIM:]
    if cos is not None:
        k_rope = apply_rope(k_rope, cos, sin)
    k_rope = jnp.broadcast_to(k_rope[:, :, None, :], (bsz, n, MLA_HEADS, MLA_ROPE_DIM))
    return jnp.concatenate([k_nope, k_rope], axis=-1), v


def blockwise_attention(q, k, v, k_ctx, v_ctx):
    bsz, n, heads, dq = q.shape
    scale = dq ** -0.5
    kk = jnp.concatenate([k, k_ctx], axis=1)
    vv = jnp.concatenate([v, v_ctx], axis=1)
    qb = q.reshape(bsz, n // Q_BLOCK, Q_BLOCK, heads, dq).transpose(1, 0, 2, 3, 4)

    def attend(qi):
        s = jnp.einsum('bqhd,bkhd->bhqk', qi, kk).astype(jnp.float32) * scale
        p = jax.nn.softmax(s, axis=-1).astype(vv.dtype)
        return jnp.einsum('bhqk,bkhd->bqhd', p, vv)

    o = lax.map(attend, qb)
    return o.transpose(1, 0, 2, 3, 4).reshape(bsz, n, heads * vv.shape[-1])


def merge_branches(branches, gate_logits, w_branch, w_out):
    bsz, n, _ = gate_logits.shape
    gates = jax.nn.sigmoid(gate_logits).reshape(bsz, n, N_BRANCH, D_MODEL)
    y = sum(gates[:, :, i] * (branches[i] @ w_branch[i]) for i in range(N_BRANCH))
    return y @ w_out


def mixing_sublayer(h, hc, cos, sin, w_in, na_rpb, lru_conv_w, lru_conv_b, lru_w_a, lru_b_a, lru_w_x, lru_b_x,
                    lru_lam, mla_q_norm, mla_kv_norm, mla_w_q_up, mla_w_kv_up, w_branch, w_out, with_ctx_out):
    bsz, n, _ = h.shape
    n_ctx = hc.shape[1]
    na_qkv, lru_x, lru_g, cq, ckv, kr, gate_logits = split_in_proj(h @ w_in)
    na_qkv_c, lru_x_c, lru_g_c, cq_c, ckv_c, kr_c, gate_logits_c = split_in_proj(hc @ w_in)
    qkv = na_qkv.reshape(bsz, n, 3, NA_HEADS, NA_HEAD_DIM)
    qkv_c = na_qkv_c.reshape(bsz, n_ctx, 3, NA_HEADS, NA_HEAD_DIM)
    out_a = neighbourhood_attention(qkv[:, :, 0], qkv[:, :, 1], qkv[:, :, 2], qkv_c[:, :, 1], qkv_c[:, :, 2], na_rpb)
    u = depthwise_conv(lru_x, lru_conv_w, lru_conv_b)
    u_c = depthwise_conv(lru_x_c, lru_conv_w, lru_conv_b)
    y_b, h_cf, h_cb = bidirectional_rglru(u, u_c, lru_w_a, lru_b_a, lru_w_x, lru_b_x, lru_lam)
    out_b = jax.nn.gelu(lru_g) * y_b
    q_m = mla_queries(cq, mla_q_norm, mla_w_q_up, cos, sin)
    k_m, v_m = mla_keys_values(ckv, kr, mla_kv_norm, mla_w_kv_up, cos, sin)
    k_mc, v_mc = mla_keys_values(ckv_c, kr_c, mla_kv_norm, mla_w_kv_up, None, None)
    out_c = blockwise_attention(q_m, k_m, v_m, k_mc, v_mc)
    y = merge_branches((out_a, out_b, out_c), gate_logits, w_branch, w_out)
    if not with_ctx_out:
        return y, None
    out_ac = softmax_attention(qkv_c[:, :, 0], qkv_c[:, :, 1], qkv_c[:, :, 2])
    out_bc = jax.nn.gelu(lru_g_c) * (h_cf + h_cb).astype(lru_g_c.dtype)
    q_mc = mla_queries(cq_c, mla_q_norm, mla_w_q_up, None, None)
    out_cc = softmax_attention(q_mc, k_mc, v_mc)
    yc = merge_branches((out_ac, out_bc, out_cc), gate_logits_c, w_branch, w_out)
    return y, yc


def conv_ffn(h, w_up, conv_w, conv_b, w_down):
    u = depthwise_conv(h @ w_up, conv_w, conv_b)
    val, gate = jnp.split(u, 2, axis=-1)
    return (jax.nn.silu(gate) * val) @ w_down


def setup_inputs(seed: int = 0) -> dict:
    key = jax.random.key(seed)
    ks = jax.random.split(key, 32)
    f32 = jnp.float32
    D = D_MODEL

    def nrm(k, shape, scale):
        return jax.random.normal(k, shape, f32) * scale

    lam_u = jax.random.uniform(ks[16], (DEPTH, 2, LRU_WIDTH), f32, 0.9, 0.999)
    lam_s = lam_u ** (1.0 / LRU_C)
    return {
        'x': nrm(ks[0], (BATCH, SEQ, D), 1.0),
        'c': nrm(ks[1], (BATCH, D), 1.0),
        'ctx': nrm(ks[2], (BATCH, CTX_LEN, D), 1.0),
        'c_ctx': nrm(ks[3], (D,), 1.0),
        'w_mod': nrm(ks[4], (DEPTH, D, N_MOD * D), 0.5 * D ** -0.5),
        'b_mod': nrm(ks[5], (DEPTH, N_MOD * D), 0.02),
        'norm_mix': 1.0 + nrm(ks[6], (DEPTH, D), 0.05),
        'norm_ffn': 1.0 + nrm(ks[7], (DEPTH, D), 0.05),
        'w_in': nrm(ks[8], (DEPTH, D, D_IN), D ** -0.5),
        'na_rpb': nrm(ks[9], (DEPTH, NA_HEADS, 2 * NA_WIN_H - 1, 2 * NA_WIN_W - 1), 0.1),
        'lru_conv_w': nrm(ks[10], (DEPTH, LRU_CONV_W, LRU_WIDTH), LRU_CONV_W ** -0.5),
        'lru_conv_b': nrm(ks[11], (DEPTH, LRU_WIDTH), 0.02),
        'lru_w_a': nrm(ks[12], (DEPTH, 2, LRU_BLOCKS, LRU_BLOCK_DIM, LRU_BLOCK_DIM), LRU_BLOCK_DIM ** -0.5),
        'lru_b_a': nrm(ks[13], (DEPTH, 2, LRU_WIDTH), 0.02),
        'lru_w_x': nrm(ks[14], (DEPTH, 2, LRU_BLOCKS, LRU_BLOCK_DIM, LRU_BLOCK_DIM), LRU_BLOCK_DIM ** -0.5),
        'lru_b_x': nrm(ks[15], (DEPTH, 2, LRU_WIDTH), 0.02),
        'lru_lam': jnp.log(lam_s) - jnp.log1p(-lam_s),
        'mla_q_norm': 1.0 + nrm(ks[17], (DEPTH, MLA_Q_RANK), 0.05),
        'mla_kv_norm': 1.0 + nrm(ks[18], (DEPTH, MLA_KV_RANK), 0.05),
        'mla_w_q_up': nrm(ks[19], (DEPTH, MLA_Q_RANK, MLA_HEADS * MLA_QK_DIM), MLA_Q_RANK ** -0.5),
        'mla_w_kv_up': nrm(ks[20], (DEPTH, MLA_KV_RANK, MLA_HEADS * (MLA_NOPE_DIM + MLA_V_DIM)), MLA_KV_RANK ** -0.5),
        'w_branch': nrm(ks[21], (DEPTH, N_BRANCH, BRANCH_WIDTH, D), BRANCH_WIDTH ** -0.5),
        'w_out': nrm(ks[22], (DEPTH, D, D), D ** -0.5),
        'ffn_w_up': nrm(ks[23], (DEPTH, D, 2 * D_FF), D ** -0.5),
        'ffn_conv_w': nrm(ks[24], (DEPTH, FFN_CONV_W, 2 * D_FF), FFN_CONV_W ** -0.5),
        'ffn_conv_b': nrm(ks[25], (DEPTH, 2 * D_FF), 0.02),
        'ffn_w_down': nrm(ks[26], (DEPTH, D_FF, D), D_FF ** -0.5),
        'norm_final': 1.0 + nrm(ks[27], (D,), 0.05),
    }


def reference(x, c, ctx, c_ctx, w_mod, b_mod, norm_mix, norm_ffn, w_in, na_rpb, lru_conv_w, lru_conv_b,
              lru_w_a, lru_b_a, lru_w_x, lru_b_x, lru_lam, mla_q_norm, mla_kv_norm, mla_w_q_up, mla_w_kv_up,
              w_branch, w_out, ffn_w_up, ffn_conv_w, ffn_conv_b, ffn_w_down, norm_final):
    n = x.shape[1]
    cos, sin = axial_rope_angles(n, MLA_ROPE_DIM)
    silu_c = jax.nn.silu(c)
    silu_cc = jax.nn.silu(c_ctx)
    xc = ctx
    for l in range(DEPTH):
        last = l == DEPTH - 1
        mod = (silu_c @ w_mod[l] + b_mod[l])[:, None, :]
        mod_c = silu_cc @ w_mod[l] + b_mod[l]
        sh1, sc1, g1, sh2, sc2, g2 = jnp.split(mod, N_MOD, axis=-1)
        sh1c, sc1c, g1c, sh2c, sc2c, g2c = jnp.split(mod_c, N_MOD, axis=-1)
        h = modulate(rmsnorm(x, norm_mix[l]), sh1, sc1)
        hc = modulate(rmsnorm(xc, norm_mix[l]), sh1c, sc1c)
        y, yc = mixing_sublayer(h, hc, cos, sin, w_in[l], na_rpb[l], lru_conv_w[l], lru_conv_b[l], lru_w_a[l],
                                lru_b_a[l], lru_w_x[l], lru_b_x[l], lru_lam[l], mla_q_norm[l], mla_kv_norm[l],
                                mla_w_q_up[l], mla_w_kv_up[l], w_branch[l], w_out[l], not last)
        x = x + g1 * y
        h2 = modulate(rmsnorm(x, norm_ffn[l]), sh2, sc2)
        x = x + g2 * conv_ffn(h2, ffn_w_up[l], ffn_conv_w[l], ffn_conv_b[l], ffn_w_down[l])
        if not last:
            xc = xc + g1c * yc
            h2c = modulate(rmsnorm(xc, norm_ffn[l]), sh2c, sc2c)
            xc = xc + g2c * conv_ffn(h2c, ffn_w_up[l], ffn_conv_w[l], ffn_conv_b[l], ffn_w_down[l])
    return rmsnorm(x, norm_final)
```

```cpp
#include <hip/hip_runtime.h>
#include <stdint.h>
#include <stdio.h>

#ifndef MK_SINGLE
#define MK_SINGLE 1
#endif

#define LAS __attribute__((address_space(3)))
typedef unsigned short bf16_t;
typedef short bf16x8 __attribute__((ext_vector_type(8)));
typedef short s16x4 __attribute__((ext_vector_type(4)));
typedef float f32x2 __attribute__((ext_vector_type(2)));
typedef float f32x4 __attribute__((ext_vector_type(4)));
typedef float f32x16 __attribute__((ext_vector_type(16)));
typedef unsigned u32x2 __attribute__((ext_vector_type(2)));
typedef unsigned u32x4 __attribute__((ext_vector_type(4)));

constexpr int DM = 2048, NB = 4, SEQ = 4096, CTXL = 256, DEPTH = 4;
constexpr int SEGT = SEQ + CTXL;
constexpr int TT = NB * SEGT;
constexpr int PAN = SEGT / 256;
constexpr int DIN_SRC = 12096, DIN = 12288;
constexpr int DFF = 5632, DFF2 = 11264;
constexpr int NTHR = 512;
constexpr float EPS = 1e-6f;
constexpr int KSPLIT = 8;

constexpr int C_QKV = 0, C_LX = 3072, C_LG = 4096, C_CQ = 5120, C_CKV = 5632, C_KR = 5888, C_SG = 6144;

constexpr size_t al256(size_t x) { return (x + 255) & ~(size_t)255; }
constexpr size_t WS_BAR = 0;
constexpr size_t WS_MOD = 16384;
constexpr size_t WS_ROPE = WS_MOD + al256((size_t)DEPTH * 5 * 12288 * 4);
constexpr size_t WS_SP8 = WS_ROPE + al256((size_t)2 * 4096 * 32 * 4);
constexpr size_t WS_HLX = WS_SP8 + al256((size_t)DEPTH * 2 * 1024 * 4);
constexpr size_t WS_SSQ = WS_HLX + al256((size_t)NB * PAN * 6 * 1024 * 4);
constexpr size_t WS_SWP = WS_SSQ + al256((size_t)8 * TT * 8);
constexpr size_t WS_SW = WS_SWP + al256((size_t)2 * 2 * 16 * 5 * 12288 * 4);
constexpr size_t WS_XS = WS_SW + al256((size_t)2 * 5 * 12288 * 4);
constexpr size_t WS_H = WS_XS + (size_t)TT * DM * 4;
constexpr size_t WS_WIN = WS_H + (size_t)TT * DM * 2;
constexpr size_t WS_WGATE = WS_WIN + (size_t)DIN * DM * 2;
constexpr size_t WS_WQ = WS_WGATE + (size_t)4096 * 256 * 2;
constexpr size_t WS_WKV = WS_WQ + (size_t)1536 * 512 * 2;
constexpr size_t WS_WBR = WS_WKV + (size_t)2048 * 256 * 2;
constexpr size_t WS_WOUT = WS_WBR + (size_t)3 * 2048 * 1024 * 2;
constexpr size_t WS_WUP = WS_WOUT + (size_t)2048 * 2048 * 2;
constexpr size_t WS_WDOWN = WS_WUP + (size_t)DFF2 * DM * 2;
constexpr size_t WSET_BYTES = WS_WDOWN + (size_t)DM * DFF * 2 - WS_WIN;
constexpr size_t WS_ARENA = WS_WIN + 2 * WSET_BYTES;
constexpr size_t WS_QKV = WS_ARENA;
constexpr size_t WS_LX = WS_QKV + (size_t)TT * 3072 * 2;
constexpr size_t WS_U = WS_LX + (size_t)TT * 1024 * 2;
constexpr size_t WS_LG = WS_U + (size_t)TT * 1024 * 2;
constexpr size_t WS_CQ = WS_LG + (size_t)TT * 1024 * 2;
constexpr size_t WS_CKV = WS_CQ + (size_t)TT * 512 * 2;
constexpr size_t WS_RSQ = WS_CKV + (size_t)TT * 256 * 2;
constexpr size_t WS_RSKV = WS_RSQ + al256((size_t)TT * 4);
constexpr size_t WS_SG = WS_RSKV + al256((size_t)TT * 4);
constexpr size_t WS_KM = WS_SG + (size_t)TT * 6144;
constexpr size_t WS_VM = WS_KM + (size_t)TT * 1536 * 2;
constexpr size_t WS_QM = WS_VM + (size_t)TT * 1024 * 2;
constexpr size_t WS_BR = WS_QM + (size_t)TT * 1536 * 2;
constexpr size_t WS_PS = WS_BR + (size_t)TT * 3072 * 2;
constexpr size_t WS_AB = WS_PS + al256((size_t)2 * NB * 2 * 68 * 1024 * 4);
constexpr size_t WS_PART = WS_AB;
constexpr size_t WS_DELTA = WS_ARENA;
constexpr size_t WS_YMB = WS_AB + (size_t)2 * TT * 1024 * 4;
constexpr size_t WS_MIX_END = WS_AB + (size_t)4 * TT * 1024 * 4;
constexpr size_t WS_PF = WS_ARENA;
constexpr size_t WS_ACT = WS_PF + (size_t)TT * DFF2 * 2;
constexpr size_t WS_HALO = WS_ARENA + ((size_t)160 << 20);
constexpr size_t WS_FFN_END = WS_ACT + (size_t)TT * DFF * 2;
constexpr size_t WS_END = WS_MIX_END > WS_FFN_END ? WS_MIX_END : WS_FFN_END;

constexpr int LDS_STAGE = 131072;
constexpr int LDS_TAB = LDS_STAGE;
constexpr int LDS_BARW = LDS_STAGE + 2048;
constexpr int LDS_EXCH = LDS_STAGE + 2048 + 64;
constexpr int LDS_PF = LDS_EXCH + 12288;
constexpr int LDS_CW = LDS_PF + 6144;
constexpr int LDS_BYTES = LDS_CW + 8192;

struct Params {
    const float *x, *c, *ctx, *c_ctx, *w_mod, *b_mod, *norm_mix, *norm_ffn, *w_in, *na_rpb, *lru_conv_w, *lru_conv_b,
        *lru_w_a, *lru_b_a, *lru_w_x, *lru_b_x, *lru_lam, *mla_q_norm, *mla_kv_norm, *mla_w_q_up, *mla_w_kv_up,
        *w_branch, *w_out, *ffn_w_up, *ffn_conv_w, *ffn_conv_b, *ffn_w_down, *norm_final;
    float* out; unsigned char* ws;
    int ph_lo, ph_hi;
};

__device__ __forceinline__ unsigned cvt_pk_bf16(float lo, float hi) { unsigned r; asm("v_cvt_pk_bf16_f32 %0, %1, %2" : "=v"(r) : "v"(lo), "v"(hi)); return r; }
__device__ __forceinline__ float bflo(unsigned w) { return __uint_as_float(w << 16); }
__device__ __forceinline__ float bfhi(unsigned w) { return __uint_as_float(w & 0xffff0000u); }
__device__ __forceinline__ float bf2f(bf16_t v) { return __uint_as_float(((unsigned)v) << 16); }
__device__ __forceinline__ bf16_t f2bf(float f) { return (bf16_t)(cvt_pk_bf16(f, 0.f) & 0xffffu); }
typedef _Float16 h16x2 __attribute__((ext_vector_type(2)));
__device__ __forceinline__ unsigned pack_h2(float a, float b) { h16x2 v; v.x = (_Float16)a; v.y = (_Float16)b; return __builtin_bit_cast(unsigned, v); }
__device__ __forceinline__ float h2lo(unsigned w) { return (float)__builtin_bit_cast(h16x2, w).x; }
__device__ __forceinline__ float h2hi(unsigned w) { return (float)__builtin_bit_cast(h16x2, w).y; }
__device__ __forceinline__ float fast_exp(float x) { return __builtin_amdgcn_exp2f(x * 1.4426950408889634f); }
__device__ __forceinline__ float fast_sigmoid(float x) { return __builtin_amdgcn_rcpf(1.f + fast_exp(-x)); }
__device__ __forceinline__ float gelu_tanh(float x) { const float u = 0.7978845608028654f * (x + 0.044715f * x * x * x); return x * fast_sigmoid(2.f * u); }
__device__ __forceinline__ float silu_f(float x) { return x * fast_sigmoid(x); }
__device__ __forceinline__ float wave_sum(float v) {
#pragma unroll
    for (int o = 32; o > 0; o >>= 1) v += __shfl_xor(v, o, 64);
    return v;
}
__device__ __forceinline__ int row_batch(int r) { return r / SEGT; }

#define XB_TMO      128
#define XB_XCNT(j)  (256  + 64 * (j))
#define XB_XSUB(j)  (1280 + 64 * (j))
#define XB_XGEN(j)  (2304 + 64 * (j))
#define XB_TOP      3328
#define XB_TOPGEN   3392
#define XCD_BAR_WORDS 3456
#define XB_SPIN_CAP (1u << 22)
__device__ __forceinline__ unsigned xb_ld(unsigned* p)              { return __hip_atomic_load(p, __ATOMIC_RELAXED, __HIP_MEMORY_SCOPE_AGENT); }
__device__ __forceinline__ unsigned xb_add(unsigned* p, unsigned v) { return __hip_atomic_fetch_add(p, v, __ATOMIC_RELAXED, __HIP_MEMORY_SCOPE_AGENT); }
__device__ __forceinline__ unsigned xb_xcc_id() { return (unsigned)__builtin_amdgcn_s_getreg((3 << 11) | 20) & 0xFu; }
#define XB_SPIN(cond, bar) do { unsigned _sp = 0; while (cond) { __builtin_amdgcn_s_sleep(1); \
    if ((++_sp & 255u) == 0u) { if (xb_ld(&(bar)[XB_TMO])) break; if (_sp > XB_SPIN_CAP) { atomicAdd(&(bar)[XB_TMO], 1u); break; } } } } while (0)
struct XcdBarrier { unsigned* bar; unsigned x; volatile LAS unsigned* st; };
__device__ __forceinline__ XcdBarrier xcd_barrier_post(unsigned* bar, volatile LAS unsigned* st) {
    XcdBarrier b; b.bar = bar; b.x = xb_xcc_id(); b.st = st;
    if (threadIdx.x == 0) (void)xb_add(&bar[XB_XCNT(b.x)], 1u);
    return b;
}
__device__ __forceinline__ void xcd_barrier_complete(unsigned* bar, unsigned x, unsigned& nloc, unsigned& nx) {
    const unsigned G = gridDim.x * gridDim.y * gridDim.z;
    unsigned sum, cnt, mine, sp = 0u;
    for (;;) {
        sum = 0u; cnt = 0u; mine = 0u;
#pragma unroll
        for (unsigned j = 0; j < 16; ++j) { const unsigned c = xb_ld(&bar[XB_XCNT(j)]); sum += c; cnt += (c > 0u) ? 1u : 0u; mine = (j == x) ? c : mine; }
        if (sum == G) break;
        __builtin_amdgcn_s_sleep(1);
        if ((++sp & 255u) == 0u) { if (xb_ld(&bar[XB_TMO])) break; if (sp > XB_SPIN_CAP) { atomicAdd(&bar[XB_TMO], 1u); break; } }
    }
    nloc = mine > 0u ? mine : 1u; nx = cnt > 0u ? cnt : 1u;
}
__device__ __forceinline__ void xcd_barrier(const XcdBarrier& b) {
    asm volatile("s_waitcnt vmcnt(0)" ::: "memory");
    __syncthreads();
    int tz_ = threadIdx.x; asm volatile("" : "+v"(tz_));
    if (tz_ == 0) {
        unsigned* bar = b.bar;
        __builtin_amdgcn_s_waitcnt(0);
        unsigned nloc = b.st[0], nx = b.st[1];
        if (nloc == 0u) { xcd_barrier_complete(bar, b.x, nloc, nx); b.st[0] = nloc; b.st[1] = nx; }
        const unsigned old = xb_add(&bar[XB_XSUB(b.x)], 1u);
        const unsigned gen = old / nloc;
        if (old + 1u == (gen + 1u) * nloc) {
            __builtin_amdgcn_fence(__ATOMIC_RELEASE, "agent");
            asm volatile("s_waitcnt vmcnt(0)" ::: "memory");
            const unsigned og = xb_add(&bar[XB_TOP], 1u);
            const unsigned tg = og / nx;
            if (og + 1u == (tg + 1u) * nx) xb_add(&bar[XB_TOPGEN], 1u);
            else XB_SPIN(xb_ld(&bar[XB_TOPGEN]) == tg, bar);
            __builtin_amdgcn_fence(__ATOMIC_ACQUIRE, "agent");
            xb_add(&bar[XB_XGEN(b.x)], 1u);
            asm volatile("s_waitcnt vmcnt(0)" ::: "memory");
        } else {
            XB_SPIN(xb_ld(&bar[XB_XGEN(b.x)]) == gen, bar);
            __builtin_amdgcn_fence(__ATOMIC_ACQUIRE, "agent");
            asm volatile("s_waitcnt vmcnt(0)" ::: "memory");
        }
    }
    __syncthreads();
}

__device__ __forceinline__ void split_arrive(unsigned* bar, int k) {
    asm volatile("s_waitcnt vmcnt(0)" ::: "memory");
    __syncthreads();
    int tz_ = threadIdx.x; asm volatile("" : "+v"(tz_));
    if (tz_ == 0) { __builtin_amdgcn_fence(__ATOMIC_RELEASE, "agent"); asm volatile("s_waitcnt vmcnt(0)" ::: "memory"); (void)xb_add(&bar[3584 + 32 * k], 1u); }
}
__device__ __forceinline__ void split_wait(unsigned* bar, int k, unsigned G) {
    int tz_ = threadIdx.x; asm volatile("" : "+v"(tz_));
    if (tz_ == 0) { XB_SPIN(xb_ld(&bar[3584 + 32 * k]) < G, bar); __builtin_amdgcn_fence(__ATOMIC_ACQUIRE, "agent"); asm volatile("s_waitcnt vmcnt(0)" ::: "memory"); }
    __builtin_amdgcn_s_barrier();
}

namespace pg8 {
constexpr int BM = 256, BK = 64, HALF = 128, HTB = HALF * BK * 2, STAGE_BYTES = 8 * HTB, NXCD = 8, WGM = 8;
__host__ __device__ __forceinline__ int lds_byte(int r, int c) { const int st = (r >> 4) * 2 + (c >> 5), rr = r & 15, cc = c & 31, ob = rr * 64 + cc * 2; return st * 1024 + (ob ^ (((ob >> 9) & 1) << 5)); }
__host__ __device__ __forceinline__ void stage_rc(int b, int& R, int& C) { const int st = b / 1024, sb = b % 1024, swz = sb ^ (((sb >> 9) & 1) << 5); R = (st >> 1) * 16 + swz / 64; C = (st & 1) * 32 + (swz % 64) / 2; }
__host__ __device__ __forceinline__ int perm32(int rho) { const int n = rho >> 4, i = rho & 15; return 8 * (i >> 2) + 4 * n + (i & 3); }
struct Unit { int pm, pn, k0, nk, split, par; };
struct Gemm { const bf16_t* A; int lda; const bf16_t* Bt; int ldb; int M, N, K; int amask, ashift, astep; };
struct Order {
    int nM, nN, nwg, G, c, nkt, mode, S;
    __device__ void init(int N, int K, int G_, int c_, int mode_, int S_) { mode = mode_; S = S_; nM = mode == 0 ? NB * PAN : NB * 16; nN = N / BM; nwg = nM * nN; G = G_; c = c_; nkt = K / BK; }
    __device__ bool next(int i, Unit& u) const {
        const long L = (long)i * G + c;
        if (L < nwg) {
            int wgid = (int)L; { const int q = nwg / NXCD, r = nwg % NXCD, xcd = wgid % NXCD, off = wgid / NXCD; wgid = (xcd < r ? xcd * (q + 1) : r * (q + 1) + (xcd - r) * q) + off; }
            const int nig = WGM * nN, gid = wgid / nig, fm = gid * WGM, gsz = (nM - fm) < WGM ? (nM - fm) : WGM;
            const int pml = fm + ((wgid % nig) % gsz); u.pn = (wgid % nig) / gsz;
            u.pm = mode == 0 ? pml : (pml >> 4) * PAN + 1 + (pml & 15);
            u.k0 = 0; u.nk = nkt; u.split = 0; return true;
        }
        if (mode == 3) {
            const long L2 = L - nwg; if (L2 >= (long)NB * nN) return false;
            u.pm = ((int)L2 / nN) * PAN; u.pn = (int)L2 % nN; u.k0 = 0; u.nk = nkt; u.split = 0; return true;
        }
        if (mode == 2) {
            const long L2 = L - nwg; if (L2 >= (long)NB * nN * S) return false;
            const int tq = (int)L2 / S, sl = (int)L2 % S; u.pm = (tq / nN) * PAN; u.pn = tq % nN;
            const int pairs = nkt >> 1, base = pairs / S, rem = pairs % S;
            u.k0 = 2 * (sl * base + (sl < rem ? sl : rem)); u.nk = 2 * (base + (sl < rem ? 1 : 0)); u.split = 1 + sl; return true;
        }
        return false;
    }
};

template <class E, class = void> struct HasPref { static constexpr bool v = false; };
template <class E> struct HasPref<E, decltype((void)E::PREF)> { static constexpr bool v = E::PREF; };
template <class E, class = void> struct HasCtxWait { static constexpr bool v = false; };
template <class E> struct HasCtxWait<E, decltype((void)E::CTXWAIT)> { static constexpr bool v = E::CTXWAIT; };
template <class E, class = void> struct HasAperm { static constexpr bool v = false; };
template <class E> struct HasAperm<E, decltype((void)E::APERM)> { static constexpr bool v = E::APERM; };
template <class Epi>
__device__ __forceinline__ void gemm_phase(LAS unsigned char* lds, const Gemm g, const Order& S, const Epi& E) {
    int tid = threadIdx.x; asm volatile("" : "+v"(tid));
    const int wid = __builtin_amdgcn_readfirstlane(tid >> 6), lane = tid & 63, wr = wid >> 2, wc = wid & 3, fr = lane & 15, fq = lane >> 4;
    unsigned voffA[2], voffB[2];
#pragma unroll
    for (int i = 0; i < 2; ++i) { int R, C; stage_rc(tid * 16 + i * 8192, R, C); const int Rb = Epi::PERM ? ((R & ~31) + perm32(R & 31)) : R;
        const int Ra = HasAperm<Epi>::v ? ((R & ~63) + 4 * (R & 15) + ((R >> 4) & 3)) : R;
        voffA[i] = (unsigned)(Ra * g.lda + C) * 2u; voffB[i] = (unsigned)(Rb * g.ldb + C) * 2u; }
    const size_t kstep = (size_t)(BK * 2);
    const size_t hstepA = (size_t)HALF * g.lda * 2, hstepB = (size_t)HALF * g.ldb * 2;
    const size_t tstepA = 2 * hstepA, tstepB = 2 * hstepB;
    const unsigned ldsw = (unsigned)wid * 1024u;
    const int aoff = lds_byte(wr * 64 + fr, fq * 8), boff = lds_byte(wc * 32 + fr, fq * 8);
#define PG8_SA(b, h) (((b) * 2 + (h)) * HTB)
#define PG8_SB(b, h) ((4 + (b) * 2 + (h)) * HTB)
#define PG8_STAGE(bufoff, gbase, voff) do { _Pragma("unroll") for (int _i = 0; _i < 2; ++_i) \
        __builtin_amdgcn_global_load_lds((const unsigned*)((const char*)(gbase) + (voff)[_i]), (LAS unsigned*)(lds + (bufoff) + ldsw + _i * 8192), 16, 0, 0); } while (0)
#define PG8_LDA(dst, b, h) do { _Pragma("unroll") for (int m = 0; m < 4; ++m) _Pragma("unroll") for (int k = 0; k < 2; ++k) dst[m][k] = *(const LAS bf16x8*)(lds + PG8_SA(b, h) + aoff + m * 2048 + k * 1024); } while (0)
#define PG8_LDB(dst, b, h) do { _Pragma("unroll") for (int n = 0; n < 2; ++n) _Pragma("unroll") for (int k = 0; k < 2; ++k) dst[n][k] = *(const LAS bf16x8*)(lds + PG8_SB(b, h) + boff + n * 2048 + k * 1024); } while (0)
#define PG8_MMA(ai, bj, At, Bt) do { __builtin_amdgcn_s_setprio(1); _Pragma("unroll") for (int m = 0; m < 4; ++m) _Pragma("unroll") for (int n = 0; n < 2; ++n) _Pragma("unroll") for (int k = 0; k < 2; ++k) \
        acc[ai][bj][m][n] = __builtin_amdgcn_mfma_f32_16x16x32_bf16(Bt[n][k], At[m][k], acc[ai][bj][m][n], 0, 0, 0); __builtin_amdgcn_s_setprio(0); } while (0)
#define PG8_WAIT_V(n) asm volatile("s_waitcnt vmcnt(" #n ")" ::: "memory")
#define PG8_WAIT_L(n) asm volatile("s_waitcnt lgkmcnt(" #n ")" ::: "memory")
#define PG8_BAR __builtin_amdgcn_s_barrier()
#define PG8_SCHED __builtin_amdgcn_sched_barrier(0)
#define PG8_AOFF(u) ((size_t)((((u).pn & g.amask) >> g.ashift) * g.astep) * 2)
    Unit cur, nxt; int ui = 0;
    if (!S.next(0, cur)) return;
    cur.par = 0; bool waited = false; (void)waited;
    f32x4 acc[2][2][4][2];
#pragma unroll
    for (int a = 0; a < 2; ++a)
#pragma unroll
        for (int b = 0; b < 2; ++b)
#pragma unroll
            for (int m = 0; m < 4; ++m)
#pragma unroll
                for (int n = 0; n < 2; ++n) acc[a][b][m][n] = (f32x4){0.f, 0.f, 0.f, 0.f};
    bf16x8 At[4][2], B0[2][2], B1[2][2];
    const char* cA = (const char*)g.A + (size_t)cur.pm * tstepA + PG8_AOFF(cur) + (size_t)cur.k0 * kstep; const char* cB = (const char*)g.Bt + (size_t)cur.pn * tstepB + (size_t)cur.k0 * kstep;
    PG8_STAGE(PG8_SB(0, 0), cB, voffB); PG8_STAGE(PG8_SA(0, 0), cA, voffA); PG8_STAGE(PG8_SB(0, 1), cB + hstepB, voffB); PG8_STAGE(PG8_SA(0, 1), cA + hstepA, voffA);
    if (wr == 1) PG8_BAR;
    PG8_WAIT_V(4); PG8_BAR;
    PG8_STAGE(PG8_SB(1, 0), cB + kstep, voffB); PG8_STAGE(PG8_SA(1, 0), cA + kstep, voffA); PG8_STAGE(PG8_SB(1, 1), cB + hstepB + kstep, voffB);
    PG8_WAIT_V(6); PG8_BAR;
    for (;;) {
        const bool has_next = S.next(ui + 1, nxt);
        const char* nA = has_next ? (const char*)g.A + (size_t)nxt.pm * tstepA + PG8_AOFF(nxt) + (size_t)nxt.k0 * kstep : cA; const char* nB = has_next ? (const char*)g.Bt + (size_t)nxt.pn * tstepB + (size_t)nxt.k0 * kstep : cB;
        const int nt = cur.nk;
        if constexpr (HasCtxWait<Epi>::v) { if (!waited && has_next && (nxt.pm % PAN) == 0) { E.ctx_wait(); waited = true; } }
        if constexpr (HasPref<Epi>::v) E.prefetch(lds, cur, wid, tid & 63);
#pragma unroll 1
        for (int t = 0; t < nt; t += 2) {
            const bool last = (t == nt - 2);
            if constexpr (Epi::KHOOK > 0) { if (t > 0 && (t % Epi::KHOOK) == 0) E.khook(acc, cur, t / Epi::KHOOK); }
            const char* a1 = cA + (size_t)(t + 1) * kstep;
            const char* a2 = last ? nA : cA + (size_t)(t + 2) * kstep; const char* b2 = last ? nB : cB + (size_t)(t + 2) * kstep;
            const char* a3 = a2 + kstep; const char* b3 = b2 + kstep;
            PG8_LDB(B0, 0, 0); PG8_SCHED; PG8_LDA(At, 0, 0); PG8_STAGE(PG8_SA(1, 1), a1 + hstepA, voffA);
            PG8_WAIT_L(8); PG8_BAR; PG8_WAIT_L(0); PG8_MMA(0, 0, At, B0); PG8_BAR; PG8_SCHED;
            PG8_LDB(B1, 0, 1); PG8_STAGE(PG8_SB(0, 0), b2, voffB);
            PG8_BAR; PG8_WAIT_L(0); PG8_MMA(0, 1, At, B1); PG8_BAR;
            PG8_LDA(At, 0, 1); PG8_STAGE(PG8_SA(0, 0), a2, voffA);
            PG8_BAR; PG8_WAIT_L(0); PG8_MMA(1, 0, At, B0); PG8_BAR; PG8_SCHED;
            PG8_STAGE(PG8_SB(0, 1), b2 + hstepB, voffB);
            PG8_WAIT_V(6); PG8_BAR; PG8_MMA(1, 1, At, B1); PG8_BAR;
            PG8_LDB(B0, 1, 0); PG8_SCHED; PG8_LDA(At, 1, 0); PG8_STAGE(PG8_SA(0, 1), a2 + hstepA, voffA);
            PG8_WAIT_L(8); PG8_BAR; PG8_WAIT_L(0); PG8_MMA(0, 0, At, B0); PG8_BAR; PG8_SCHED;
            PG8_LDB(B1, 1, 1); PG8_STAGE(PG8_SB(1, 0), b3, voffB);
            PG8_BAR; PG8_WAIT_L(0); PG8_MMA(0, 1, At, B1); PG8_BAR;
            PG8_LDA(At, 1, 1); PG8_STAGE(PG8_SA(1, 0), a3, voffA);
            PG8_BAR; PG8_WAIT_L(0); PG8_MMA(1, 0, At, B0); PG8_BAR; PG8_SCHED;
            PG8_STAGE(PG8_SB(1, 1), b3 + hstepB, voffB);
            PG8_WAIT_V(6); PG8_BAR; PG8_MMA(1, 1, At, B1); PG8_BAR;
        }
        E(acc, cur);
        if (!has_next) break;
#pragma unroll
        for (int a = 0; a < 2; ++a)
#pragma unroll
            for (int b = 0; b < 2; ++b)
#pragma unroll
                for (int m = 0; m < 4; ++m)
#pragma unroll
                    for (int n = 0; n < 2; ++n) acc[a][b][m][n] = (f32x4){0.f, 0.f, 0.f, 0.f};
        cur = nxt; cA = nA; cB = nB; ++ui; cur.par = ui & 1;
    }
    PG8_WAIT_V(0);
    if (wr == 0) PG8_BAR;
    PG8_BAR;
#undef PG8_SA
#undef PG8_SB
#undef PG8_STAGE
#undef PG8_LDA
#undef PG8_LDB
#undef PG8_MMA
#undef PG8_WAIT_V
#undef PG8_WAIT_L
#undef PG8_BAR
#undef PG8_SCHED
#undef PG8_AOFF
}
struct G3 { const bf16_t* A; const bf16_t* B; int lda, ldb, nN, nkt, amask, ashift, astep; };
struct Unit3 { int gi, pm, pn, nk; };
__device__ __forceinline__ bool next3(long L, int n0, int n1, int n2, int nN0, int nN1, int nN2, int nk0, int nk1, int nk2, Unit3& u) {
    if (L >= (long)n0 + n1 + n2) return false;
    int loc, nN, nwg;
    if (L < n0) { u.gi = 0; loc = (int)L; nN = nN0; nwg = n0; u.nk = nk0; } else if (L < (long)n0 + n1) { u.gi = 1; loc = (int)(L - n0); nN = nN1; nwg = n1; u.nk = nk1; } else { u.gi = 2; loc = (int)(L - n0 - n1); nN = nN2; nwg = n2; u.nk = nk2; }
    int wgid = loc; { const int q = nwg / NXCD, r = nwg % NXCD, xcd = wgid % NXCD, off = wgid / NXCD; wgid = (xcd < r ? xcd * (q + 1) : r * (q + 1) + (xcd - r) * q) + off; }
    const int nM = NB * PAN; const int nig = WGM * nN, gid = wgid / nig, fm = gid * WGM, gsz = (nM - fm) < WGM ? (nM - fm) : WGM;
    u.pm = fm + ((wgid % nig) % gsz); u.pn = (wgid % nig) / gsz; return true;
}
template <class E0, class E1, class E2>
__device__ __forceinline__ void gemm_phase3(LAS unsigned char* lds, const G3 g0, const G3 g1, const G3 g2, int G, int c, const E0& e0, const E1& e1, const E2& e2) {
    int tid = threadIdx.x; asm volatile("" : "+v"(tid));
    const int wid = __builtin_amdgcn_readfirstlane(tid >> 6), lane = tid & 63, wr = wid >> 2, wc = wid & 3, fr = lane & 15, fq = lane >> 4;
    const size_t kstep = (size_t)(BK * 2);
    const unsigned ldsw = (unsigned)wid * 1024u;
    const int aoff = lds_byte(wr * 64 + fr, fq * 8), boff = lds_byte(wc * 32 + fr, fq * 8);
    int R0, C0, R1, C1; stage_rc(tid * 16, R0, C0); stage_rc(tid * 16 + 8192, R1, C1);
    const int n0 = NB * PAN * g0.nN, n1 = NB * PAN * g1.nN, n2 = NB * PAN * g2.nN;
#define G3SEL(u, f) ((u).gi == 0 ? g0.f : ((u).gi == 1 ? g1.f : g2.f))
#define G3PERM(u) ((u).gi == 0 ? E0::PERM : ((u).gi == 1 ? E1::PERM : E2::PERM))
#define G3_SETUP(u, vA, vB, hA, hB, pA, pB) do { const int _lda = G3SEL(u, lda), _ldb = G3SEL(u, ldb); const bool _pm = G3PERM(u); \
        const int _Rb0 = _pm ? ((R0 & ~31) + perm32(R0 & 31)) : R0, _Rb1 = _pm ? ((R1 & ~31) + perm32(R1 & 31)) : R1; \
        const int _Ra0 = ((u).gi == 0 && E0::APERM) ? ((R0 & ~63) + 4 * (R0 & 15) + ((R0 >> 4) & 3)) : R0, _Ra1 = ((u).gi == 0 && E0::APERM) ? ((R1 & ~63) + 4 * (R1 & 15) + ((R1 >> 4) & 3)) : R1; \
        vA[0] = (unsigned)(_Ra0 * _lda + C0) * 2u; vA[1] = (unsigned)(_Ra1 * _lda + C1) * 2u; vB[0] = (unsigned)(_Rb0 * _ldb + C0) * 2u; vB[1] = (unsigned)(_Rb1 * _ldb + C1) * 2u; \
        hA = (size_t)HALF * _lda * 2; hB = (size_t)HALF * _ldb * 2; \
        pA = (const char*)G3SEL(u, A) + (size_t)(u).pm * 2 * hA + (size_t)((((u).pn & G3SEL(u, amask)) >> G3SEL(u, ashift)) * G3SEL(u, astep)) * 2; \
        pB = (const char*)G3SEL(u, B) + (size_t)(u).pn * 2 * hB; } while (0)
#define PG8_SA(b, h) (((b) * 2 + (h)) * HTB)
#define PG8_SB(b, h) ((4 + (b) * 2 + (h)) * HTB)
#define PG8_STAGE(bufoff, gbase, voff) do { _Pragma("unroll") for (int _i = 0; _i < 2; ++_i) \
        __builtin_amdgcn_global_load_lds((const unsigned*)((const char*)(gbase) + (voff)[_i]), (LAS unsigned*)(lds + (bufoff) + ldsw + _i * 8192), 16, 0, 0); } while (0)
#define PG8_LDA(dst, b, h) do { _Pragma("unroll") for (int m = 0; m < 4; ++m) _Pragma("unroll") for (int k = 0; k < 2; ++k) dst[m][k] = *(const LAS bf16x8*)(lds + PG8_SA(b, h) + aoff + m * 2048 + k * 1024); } while (0)
#define PG8_LDB(dst, b, h) do { _Pragma("unroll") for (int n = 0; n < 2; ++n) _Pragma("unroll") for (int k = 0; k < 2; ++k) dst[n][k] = *(const LAS bf16x8*)(lds + PG8_SB(b, h) + boff + n * 2048 + k * 1024); } while (0)
#define PG8_MMA(ai, bj, At, Bt) do { __builtin_amdgcn_s_setprio(1); _Pragma("unroll") for (int m = 0; m < 4; ++m) _Pragma("unroll") for (int n = 0; n < 2; ++n) _Pragma("unroll") for (int k = 0; k < 2; ++k) \
        acc[ai][bj][m][n] = __builtin_amdgcn_mfma_f32_16x16x32_bf16(Bt[n][k], At[m][k], acc[ai][bj][m][n], 0, 0, 0); __builtin_amdgcn_s_setprio(0); } while (0)
#define PG8_WAIT_V(n) asm volatile("s_waitcnt vmcnt(" #n ")" ::: "memory")
#define PG8_WAIT_L(n) asm volatile("s_waitcnt lgkmcnt(" #n ")" ::: "memory")
#define PG8_BAR __builtin_amdgcn_s_barrier()
#define PG8_SCHED __builtin_amdgcn_sched_barrier(0)
    Unit3 cur, nxt; int ui = 0;
    if (!next3((long)c, n0, n1, n2, g0.nN, g1.nN, g2.nN, g0.nkt, g1.nkt, g2.nkt, cur)) return;
    f32x4 acc[2][2][4][2];
#pragma unroll
    for (int a = 0; a < 2; ++a)
#pragma unroll
        for (int b = 0; b < 2; ++b)
#pragma unroll
            for (int m = 0; m < 4; ++m)
#pragma unroll
                for (int n = 0; n < 2; ++n) acc[a][b][m][n] = (f32x4){0.f, 0.f, 0.f, 0.f};
    bf16x8 At[4][2], B0[2][2], B1[2][2];
    unsigned vAc[2], vBc[2], vAn[2], vBn[2]; size_t hAc, hBc, hAn, hBn; const char *cA, *cB, *nA, *nB;
    G3_SETUP(cur, vAc, vBc, hAc, hBc, cA, cB);
    PG8_STAGE(PG8_SB(0, 0), cB, vBc); PG8_STAGE(PG8_SA(0, 0), cA, vAc); PG8_STAGE(PG8_SB(0, 1), cB + hBc, vBc); PG8_STAGE(PG8_SA(0, 1), cA + hAc, vAc);
    if (wr == 1) PG8_BAR;
    PG8_WAIT_V(4); PG8_BAR;
    PG8_STAGE(PG8_SB(1, 0), cB + kstep, vBc); PG8_STAGE(PG8_SA(1, 0), cA + kstep, vAc); PG8_STAGE(PG8_SB(1, 1), cB + hBc + kstep, vBc);
    PG8_WAIT_V(6); PG8_BAR;
    for (;;) {
        const bool has_next = next3((long)(ui + 1) * G + c, n0, n1, n2, g0.nN, g1.nN, g2.nN, g0.nkt, g1.nkt, g2.nkt, nxt);
        if (has_next) { G3_SETUP(nxt, vAn, vBn, hAn, hBn, nA, nB); } else { vAn[0] = vAc[0]; vAn[1] = vAc[1]; vBn[0] = vBc[0]; vBn[1] = vBc[1]; hAn = hAc; hBn = hBc; nA = cA; nB = cB; }
        const int nt = cur.nk;
#pragma unroll 1
        for (int t = 0; t < nt; t += 2) {
            const bool last = (t == nt - 2);
            const char* a1 = cA + (size_t)(t + 1) * kstep;
            const char* a2 = last ? nA : cA + (size_t)(t + 2) * kstep; const char* b2 = last ? nB : cB + (size_t)(t + 2) * kstep;
            const char* a3 = a2 + kstep; const char* b3 = b2 + kstep;
            unsigned vA2[2], vB2[2]; vA2[0] = last ? vAn[0] : vAc[0]; vA2[1] = last ? vAn[1] : vAc[1]; vB2[0] = last ? vBn[0] : vBc[0]; vB2[1] = last ? vBn[1] : vBc[1];
            const size_t hA2 = last ? hAn : hAc, hB2 = last ? hBn : hBc;
            PG8_LDB(B0, 0, 0); PG8_SCHED; PG8_LDA(At, 0, 0); PG8_STAGE(PG8_SA(1, 1), a1 + hAc, vAc);
            PG8_WAIT_L(8); PG8_BAR; PG8_WAIT_L(0); PG8_MMA(0, 0, At, B0); PG8_BAR; PG8_SCHED;
            PG8_LDB(B1, 0, 1); PG8_STAGE(PG8_SB(0, 0), b2, vB2);
            PG8_BAR; PG8_WAIT_L(0); PG8_MMA(0, 1, At, B1); PG8_BAR;
            PG8_LDA(At, 0, 1); PG8_STAGE(PG8_SA(0, 0), a2, vA2);
            PG8_BAR; PG8_WAIT_L(0); PG8_MMA(1, 0, At, B0); PG8_BAR; PG8_SCHED;
            PG8_STAGE(PG8_SB(0, 1), b2 + hB2, vB2);
            PG8_WAIT_V(6); PG8_BAR; PG8_MMA(1, 1, At, B1); PG8_BAR;
            PG8_LDB(B0, 1, 0); PG8_SCHED; PG8_LDA(At, 1, 0); PG8_STAGE(PG8_SA(0, 1), a2 + hA2, vA2);
            PG8_WAIT_L(8); PG8_BAR; PG8_WAIT_L(0); PG8_MMA(0, 0, At, B0); PG8_BAR; PG8_SCHED;
            PG8_LDB(B1, 1, 1); PG8_STAGE(PG8_SB(1, 0), b3, vB2);
            PG8_BAR; PG8_WAIT_L(0); PG8_MMA(0, 1, At, B1); PG8_BAR;
            PG8_LDA(At, 1, 1); PG8_STAGE(PG8_SA(1, 0), a3, vA2);
            PG8_BAR; PG8_WAIT_L(0); PG8_MMA(1, 0, At, B0); PG8_BAR; PG8_SCHED;
            PG8_STAGE(PG8_SB(1, 1), b3 + hB2, vB2);
            PG8_WAIT_V(6); PG8_BAR; PG8_MMA(1, 1, At, B1); PG8_BAR;
        }
        { Unit u; u.pm = cur.pm; u.pn = cur.pn; u.k0 = 0; u.nk = cur.nk; u.split = 0;
          if (cur.gi == 0) e0(acc, u); else if (cur.gi == 1) e1(acc, u); else e2(acc, u); }
        if (!has_next) break;
#pragma unroll
        for (int a = 0; a < 2; ++a)
#pragma unroll
            for (int b = 0; b < 2; ++b)
#pragma unroll
                for (int m = 0; m < 4; ++m)
#pragma unroll
                    for (int n = 0; n < 2; ++n) acc[a][b][m][n] = (f32x4){0.f, 0.f, 0.f, 0.f};
        cur = nxt; cA = nA; cB = nB; vAc[0] = vAn[0]; vAc[1] = vAn[1]; vBc[0] = vBn[0]; vBc[1] = vBn[1]; hAc = hAn; hBc = hBn; ++ui;
    }
    PG8_WAIT_V(0);
    if (wr == 0) PG8_BAR;
    PG8_BAR;
#undef G3SEL
#undef G3PERM
#undef G3_SETUP
#undef PG8_SA
#undef PG8_SB
#undef PG8_STAGE
#undef PG8_LDA
#undef PG8_LDB
#undef PG8_MMA
#undef PG8_WAIT_V
#undef PG8_WAIT_L
#undef PG8_BAR
#undef PG8_SCHED
}
}
typedef f32x4 AccT[2][2][4][2];
struct RowScale {
    const unsigned char* ssq; const float* sw;
    unsigned* sbar; int sk; unsigned sG;
    __device__ __forceinline__ void ctx_wait() const { if (sk >= 0) split_wait(sbar, sk, sG); }
    __device__ __forceinline__ void prefetch(LAS unsigned char* lds, const pg8::Unit& u, int wid, int lane) const {
        LAS unsigned char* d = lds + LDS_PF + u.par * 3072 + wid * 256;
        __builtin_amdgcn_global_load_lds((const unsigned*)((const char*)ssq + (size_t)u.pm * 2048 + wid * 256 + lane * 4), (LAS unsigned*)d, 4, 0, 0);
        if (wid < 4) { const int b = u.pm / PAN, seg = u.pm % PAN, mr = seg == 0 ? 4 : b;
            __builtin_amdgcn_global_load_lds((const unsigned*)((const char*)(sw + (size_t)mr * 12288 + u.pn * 256) + wid * 256 + lane * 4), (LAS unsigned*)(d + 2048), 4, 0, 0); }
    }
    __device__ __forceinline__ void apply(AccT& acc, const pg8::Unit& u, const char* lds, int wr, int wc, int fr, int fq) const {
        const unsigned long long* sq = (const unsigned long long*)(lds + LDS_PF + u.par * 3072) + wr * 64 + 4 * fr;
        const float* sl = (const float*)(lds + LDS_PF + u.par * 3072 + 2048) + wc * 32 + 8 * fq;
        f32x4 swv[2][2];
#pragma unroll
        for (int bj = 0; bj < 2; ++bj)
#pragma unroll
            for (int n = 0; n < 2; ++n) swv[bj][n] = *(const f32x4*)(sl + bj * 128 + 4 * n);
#pragma unroll
        for (int ai = 0; ai < 2; ++ai)
#pragma unroll
            for (int m = 0; m < 4; ++m) { const float rs = rsqrtf(__ull2float_rn(sq[ai * 128 + m]) * (1.f / (16777216.f * 2048.f)) + EPS);
#pragma unroll
                for (int bj = 0; bj < 2; ++bj)
#pragma unroll
                    for (int n = 0; n < 2; ++n) acc[ai][bj][m][n] = acc[ai][bj][m][n] * rs + swv[bj][n]; }
    }
};
#define EPI_LANES() int _tz = threadIdx.x; asm volatile("" : "+v"(_tz)); const int _wid = __builtin_amdgcn_readfirstlane(_tz >> 6); \
    const int wr = _wid >> 2, wc = _wid & 3, fr = _tz & 15, fq = (_tz >> 4) & 3;

__device__ __forceinline__ u32x4 pack8(f32x4 v0, f32x4 v1) { u32x4 w; w.x = cvt_pk_bf16(v0[0], v0[1]); w.y = cvt_pk_bf16(v0[2], v0[3]); w.z = cvt_pk_bf16(v1[0], v1[1]); w.w = cvt_pk_bf16(v1[2], v1[3]); return w; }

__device__ __forceinline__ float dpp_shr1(float old, float src) { return __int_as_float(__builtin_amdgcn_update_dpp(__float_as_int(old), __float_as_int(src), 0x111, 0xf, 0xf, false)); }
__device__ __forceinline__ float dpp_shl1(float old, float src) { return __int_as_float(__builtin_amdgcn_update_dpp(__float_as_int(old), __float_as_int(src), 0x101, 0xf, 0xf, false)); }
struct EpiInProj {
    static constexpr bool PERM = true; static constexpr int KHOOK = 0; static constexpr bool APERM = true; static constexpr bool PREF = true; static constexpr bool CTXWAIT = true;
    __device__ __forceinline__ void ctx_wait() const { rsc.ctx_wait(); }
    unsigned char* ws; const float* rope; const float* lcw; const float* lcb; char* lds; RowScale rsc;
    __device__ __forceinline__ void prefetch(LAS unsigned char* l, const pg8::Unit& u, int wid, int lane) const { rsc.prefetch(l, u, wid, lane); }
    __device__ __forceinline__ void lru_conv(const AccT& acc, const pg8::Unit& u, int wr, int wc, int fr, int fq, int cbase) const {
        float* EX = (float*)(lds + LDS_EXCH);
        if (fr == 0 || fr == 15) {
#pragma unroll
            for (int ai = 0; ai < 2; ++ai)
#pragma unroll
                for (int bj = 0; bj < 2; ++bj)
#pragma unroll
                    for (int n = 0; n < 2; ++n) {
                        float* e = EX + ((ai * 2 + wr) * 3 * 4 + wc) * 64 + ((bj * 4 + fq) * 2 + n) * 4;
                        if (fr == 0) *(f32x4*)e = acc[ai][bj][0][n];
                        else { *(f32x4*)(e + 256) = acc[ai][bj][3][n]; *(f32x4*)(e + 512) = acc[ai][bj][2][n]; }
                    }
        }
        {
            float* HL = (float*)(ws + WS_HLX) + (size_t)u.pm * 6 * 1024 + cbase + wc * 32 + 8 * fq;
            if (wr == 0 && fr == 0) {
#pragma unroll
                for (int m = 0; m < 3; ++m)
#pragma unroll
                    for (int bj = 0; bj < 2; ++bj)
#pragma unroll
                        for (int n = 0; n < 2; ++n) *(f32x4*)(HL + (size_t)m * 1024 + bj * 128 + 4 * n) = acc[0][bj][m][n];
            }
            if (wr == 1 && fr == 15) {
#pragma unroll
                for (int m = 1; m < 4; ++m)
#pragma unroll
                    for (int bj = 0; bj < 2; ++bj)
#pragma unroll
                        for (int n = 0; n < 2; ++n) *(f32x4*)(HL + (size_t)(2 + m) * 1024 + bj * 128 + 4 * n) = acc[1][bj][m][n];
            }
        }
        asm volatile("s_waitcnt lgkmcnt(0)" ::: "memory");
        __builtin_amdgcn_s_barrier();
        __builtin_amdgcn_s_barrier();
        asm volatile("" ::: "memory");
        bf16_t* U = (bf16_t*)(ws + WS_U);
        const int row0 = u.pm * 256 + wr * 64 + 4 * fr;
#pragma unroll
        for (int ai = 0; ai < 2; ++ai) {
            const int blk = ai * 2 + wr;
#pragma unroll
            for (int bj = 0; bj < 2; ++bj) {
                u32x2 outw[4][2];
#pragma unroll
                for (int n = 0; n < 2; ++n) {
                    const int c = cbase + bj * 128 + wc * 32 + 8 * fq + 4 * n;
                    const f32x4 w0 = *(const f32x4*)(lcw + c), w1 = *(const f32x4*)(lcw + 1024 + c), w2 = *(const f32x4*)(lcw + 2048 + c), w3 = *(const f32x4*)(lcw + 3072 + c), bb = *(const f32x4*)(lcb + c);
                    f32x4 t1 = {0.f, 0.f, 0.f, 0.f}, t2 = t1, b1 = t1;
                    const int eo = ((bj * 4 + fq) * 2 + n) * 4;
                    if (blk > 0) { const float* e = EX + (((blk - 1) * 3) * 4 + wc) * 64 + eo; t1 = *(const f32x4*)(e + 256); t2 = *(const f32x4*)(e + 512); }
                    if (blk < 3) { const float* e = EX + (((blk + 1) * 3) * 4 + wc) * 64 + eo; b1 = *(const f32x4*)e; }
                    f32x4 xm1, xm2, xp1;
#pragma unroll
                    for (int j = 0; j < 4; ++j) { xm1[j] = dpp_shr1(t1[j], acc[ai][bj][3][n][j]); xm2[j] = dpp_shr1(t2[j], acc[ai][bj][2][n][j]); xp1[j] = dpp_shl1(b1[j], acc[ai][bj][0][n][j]); }
                    const f32x4 x0 = acc[ai][bj][0][n], x1 = acc[ai][bj][1][n], x2 = acc[ai][bj][2][n], x3 = acc[ai][bj][3][n];
                    const f32x4 u0 = bb + w0 * xm2 + w1 * xm1 + w2 * x0 + w3 * x1;
                    const f32x4 u1 = bb + w0 * xm1 + w1 * x0 + w2 * x1 + w3 * x2;
                    const f32x4 u2 = bb + w0 * x0 + w1 * x1 + w2 * x2 + w3 * x3;
                    const f32x4 u3 = bb + w0 * x1 + w1 * x2 + w2 * x3 + w3 * xp1;
                    outw[0][n].x = cvt_pk_bf16(u0[0], u0[1]); outw[0][n].y = cvt_pk_bf16(u0[2], u0[3]); outw[1][n].x = cvt_pk_bf16(u1[0], u1[1]); outw[1][n].y = cvt_pk_bf16(u1[2], u1[3]);
                    outw[2][n].x = cvt_pk_bf16(u2[0], u2[1]); outw[2][n].y = cvt_pk_bf16(u2[2], u2[3]); outw[3][n].x = cvt_pk_bf16(u3[0], u3[1]); outw[3][n].y = cvt_pk_bf16(u3[2], u3[3]);
                }
#pragma unroll
                for (int m = 0; m < 4; ++m) { u32x4 w; w.x = outw[m][0].x; w.y = outw[m][0].y; w.z = outw[m][1].x; w.w = outw[m][1].y;
                    *(u32x4*)(U + (size_t)(row0 + ai * 128 + m) * 1024 + cbase + bj * 128 + wc * 32 + 8 * fq) = w; }
            }
        }
    }
    __device__ __forceinline__ void operator()(AccT& acc, const pg8::Unit& u) const {
        EPI_LANES();
        rsc.apply(acc, u, lds, wr, wc, fr, fq);
        const int pn = u.pn; const int seg = u.pm % PAN;
        bf16_t* dst; int ld, cbase; int mode;
        if (pn < 12) { dst = (bf16_t*)(ws + WS_QKV); ld = 3072; cbase = pn * 256; mode = 0; }
        else if (pn < 16) { dst = (bf16_t*)(ws + WS_U); ld = 1024; cbase = (pn - 12) * 256; mode = 4; }
        else if (pn < 20) { dst = (bf16_t*)(ws + WS_LG); ld = 1024; cbase = (pn - 16) * 256; mode = 1; }
        else if (pn < 22) { dst = (bf16_t*)(ws + WS_CQ); ld = 512; cbase = (pn - 20) * 256; mode = 0; }
        else if (pn < 23) { dst = (bf16_t*)(ws + WS_CKV); ld = 256; cbase = 0; mode = 0; }
        else if (pn < 24) { dst = (bf16_t*)(ws + WS_KM); ld = 1536; cbase = 0; mode = 3; }
        else { dst = nullptr; ld = 6144; cbase = (pn - 24) * 256; mode = 2; }
        const int row0 = u.pm * 256 + wr * 64 + 4 * fr;
        if (mode == 4) { lru_conv(acc, u, wr, wc, fr, fq, cbase); return; }
        if (mode == 3) {
            if (wc >= 2) return;
            const int cl = wc * 32 + 8 * fq;
            f32x4 csv[8], snv[8];
#pragma unroll
            for (int q = 0; q < 8; ++q) { const int pos = seg != 0 ? (seg - 1) * 256 + (wr * 64 + 4 * fr + (q >> 2) * 128 + (q & 3)) : 0;
                csv[q] = *(const f32x4*)(rope + (size_t)pos * 32 + (cl >> 1)); snv[q] = *(const f32x4*)(rope + (size_t)4096 * 32 + (size_t)pos * 32 + (cl >> 1)); }
            asm volatile("" ::: "memory");
#pragma unroll
            for (int ai = 0; ai < 2; ++ai)
#pragma unroll
                for (int m = 0; m < 4; ++m) {
                    const int r = row0 + ai * 128 + m;
                    f32x4 v0 = acc[ai][0][m][0], v1 = acc[ai][0][m][1];
                    if (seg != 0) {
                        const f32x4 cs = csv[ai * 4 + m];
                        const f32x4 sn = snv[ai * 4 + m];
                        f32x4 o0, o1;
                        o0[0] = v0[0] * cs[0] - v0[1] * sn[0]; o0[1] = v0[0] * sn[0] + v0[1] * cs[0];
                        o0[2] = v0[2] * cs[1] - v0[3] * sn[1]; o0[3] = v0[2] * sn[1] + v0[3] * cs[1];
                        o1[0] = v1[0] * cs[2] - v1[1] * sn[2]; o1[1] = v1[0] * sn[2] + v1[1] * cs[2];
                        o1[2] = v1[2] * cs[3] - v1[3] * sn[3]; o1[3] = v1[2] * sn[3] + v1[3] * cs[3];
                        v0 = o0; v1 = o1;
                    }
                    const u32x4 w = pack8(v0, v1);
                    bf16_t* rp = dst + (size_t)r * 1536 + 128 + cl;
#pragma unroll
                    for (int h = 0; h < 8; ++h) *(u32x4*)(rp + h * 192) = w;
                }
            return;
        }
        if (mode == 2) {
            unsigned char* SGB = ws + WS_SG;
#pragma unroll
            for (int ai = 0; ai < 2; ++ai)
#pragma unroll
                for (int m = 0; m < 4; ++m) {
                    unsigned char* rp = SGB + (size_t)(row0 + ai * 128 + m) * 6144 + cbase + wc * 32 + 8 * fq;
#pragma unroll
                    for (int bj = 0; bj < 2; ++bj) {
                        unsigned q[8];
#pragma unroll
                        for (int n = 0; n < 2; ++n) {
                            const f32x4 tt = acc[ai][bj][m][n] * (-1.4426950408889634f);
                            const f32x4 dd = (f32x4){__builtin_amdgcn_exp2f(tt[0]), __builtin_amdgcn_exp2f(tt[1]), __builtin_amdgcn_exp2f(tt[2]), __builtin_amdgcn_exp2f(tt[3])} + 1.f;
                            const f32x4 sg = (f32x4){__builtin_amdgcn_rcpf(dd[0]), __builtin_amdgcn_rcpf(dd[1]), __builtin_amdgcn_rcpf(dd[2]), __builtin_amdgcn_rcpf(dd[3])} * 256.f;
#pragma unroll
                            for (int j = 0; j < 4; ++j) q[4 * n + j] = (unsigned)fminf(sg[j], 255.f);
                        }
                        u32x2 w; w.x = q[0] | (q[1] << 8) | (q[2] << 16) | (q[3] << 24); w.y = q[4] | (q[5] << 8) | (q[6] << 16) | (q[7] << 24);
                        *(u32x2*)(rp + bj * 128) = w;
                    }
                }
            return;
        }
#pragma unroll
        for (int ai = 0; ai < 2; ++ai)
#pragma unroll
            for (int m = 0; m < 4; ++m) {
                bf16_t* rp = dst + (size_t)(row0 + ai * 128 + m) * ld + cbase + wc * 32 + 8 * fq;
#pragma unroll
                for (int bj = 0; bj < 2; ++bj) {
                    f32x4 v0 = acc[ai][bj][m][0], v1 = acc[ai][bj][m][1];
                    if (mode == 1) {
#define GELU4(v) do { const f32x4 _t = (v) * ((v) * (v) * (0.044715f * 2.f * 0.7978845608028654f * -1.4426950408889634f) + (2.f * 0.7978845608028654f * -1.4426950408889634f)); \
                        const f32x4 _d = (f32x4){__builtin_amdgcn_exp2f(_t[0]), __builtin_amdgcn_exp2f(_t[1]), __builtin_amdgcn_exp2f(_t[2]), __builtin_amdgcn_exp2f(_t[3])} + 1.f; \
                        (v) = (v) * (f32x4){__builtin_amdgcn_rcpf(_d[0]), __builtin_amdgcn_rcpf(_d[1]), __builtin_amdgcn_rcpf(_d[2]), __builtin_amdgcn_rcpf(_d[3])}; } while (0)
                        GELU4(v0); GELU4(v1);
#undef GELU4
                    }
                    *(u32x4*)(rp + bj * 128) = pack8(v0, v1);
                }
            }
    }
};

template <int CTRL> __device__ __forceinline__ float dpp_get(float v) { return __int_as_float(__builtin_amdgcn_update_dpp(__float_as_int(v), __float_as_int(v), CTRL, 0xf, 0xf, false)); }
struct EpiGates {
    static constexpr bool PERM = false; static constexpr int KHOOK = 0; static constexpr bool APERM = true;
    unsigned char* ws; const float *b_a, *b_x, *sp8;
    __device__ __forceinline__ void operator()(const AccT& acc, const pg8::Unit& u) const {
        EPI_LANES();
        const int d = u.pn >> 3, blk = u.pn & 7;
        unsigned* AB = (unsigned*)(ws + WS_AB) + (size_t)d * TT * 1024;
        const bf16_t* U = (const bf16_t*)(ws + WS_U);
        float* Pp = (float*)(ws + WS_PS); float* Sp = Pp + (size_t)NB * 2 * 68 * 1024;
        const int bb = u.pm / PAN, seg = u.pm % PAN;
        f32x4 ba[2], bx[2], spm[2];
#pragma unroll
        for (int n = 0; n < 2; ++n) { const int c = blk * 128 + wc * 32 + 16 * n + 4 * fq;
            ba[n] = *(const f32x4*)(b_a + d * 1024 + c); bx[n] = *(const f32x4*)(b_x + d * 1024 + c); spm[n] = *(const f32x4*)(sp8 + d * 1024 + c) * (-2.f / 65535.f); }
#pragma unroll
        for (int ai = 0; ai < 2; ++ai) {
            const size_t tok0 = (size_t)u.pm * 256 + ai * 128 + wr * 64 + 4 * fr;
            u32x2 uwv[2][4];
#pragma unroll
            for (int n = 0; n < 2; ++n)
#pragma unroll
                for (int m = 0; m < 4; ++m) uwv[n][m] = *(const u32x2*)(U + (tok0 + m) * 1024 + blk * 128 + wc * 32 + 16 * n + 4 * fq);
            asm volatile("" ::: "memory");
#pragma unroll
            for (int n = 0; n < 2; ++n) { const int c = blk * 128 + wc * 32 + 16 * n + 4 * fq;
                f32x4 Pt, St;
#pragma unroll
                for (int j = 0; j < 4; ++j) { Pt[j] = 1.f; St[j] = 0.f; }
                float av[4][4], bv[4][4];
#pragma unroll
                for (int m = 0; m < 4; ++m) {
                    const u32x2 uw = uwv[n][m];
                    const float uu[4] = {bflo(uw.x), bfhi(uw.x), bflo(uw.y), bfhi(uw.y)};
                    u32x4 ow;
#pragma unroll
                    for (int jp = 0; jp < 2; ++jp) {
                        const int j0 = 2 * jp, j1 = 2 * jp + 1;
                        const f32x2 ga = (f32x2){acc[ai][0][m][n][j0] + ba[n][j0], acc[ai][0][m][n][j1] + ba[n][j1]};
                        const f32x2 gx = (f32x2){acc[ai][1][m][n][j0] + bx[n][j0], acc[ai][1][m][n][j1] + bx[n][j1]};
                        const f32x2 ta = ga * (-1.4426950408889634f), tx = gx * (-1.4426950408889634f);
                        const f32x2 da = (f32x2){__builtin_amdgcn_exp2f(ta.x), __builtin_amdgcn_exp2f(ta.y)} + 1.f, dx = (f32x2){__builtin_amdgcn_exp2f(tx.x), __builtin_amdgcn_exp2f(tx.y)} + 1.f;
                        const f32x2 rg = (f32x2){__builtin_amdgcn_rcpf(da.x), __builtin_amdgcn_rcpf(da.y)}, ig = (f32x2){__builtin_amdgcn_rcpf(dx.x), __builtin_amdgcn_rcpf(dx.y)};
                        const f32x2 rs = rg * 65535.f + 0.5f;
                        const unsigned rq0 = (unsigned)rs.x, rq1 = (unsigned)rs.y;
                        const f32x2 x2 = (f32x2){(float)rq0, (float)rq1} * (f32x2){spm[n][j0], spm[n][j1]};
                        const f32x2 ea = x2 * (0.5f * 1.4426950408889634f);
                        const f32x2 aa = (f32x2){__builtin_amdgcn_exp2f(ea.x), __builtin_amdgcn_exp2f(ea.y)};
                        f32x2 q = x2 * 0.25f + 1.f; q = q * (x2 * (1.f / 3.f)) + 1.f; q = q * (x2 * 0.5f) + 1.f;
                        const f32x2 ser = -x2 * q, dir = 1.f - aa * aa;
                        const f32x2 om = (f32x2){x2.x > -0.25f ? ser.x : dir.x, x2.y > -0.25f ? ser.y : dir.y};
                        const f32x2 iu = ig * (f32x2){uu[j0], uu[j1]};
                        const f32x2 bbv = (f32x2){__builtin_amdgcn_sqrtf(om.x), __builtin_amdgcn_sqrtf(om.y)} * iu;
                        const unsigned bw0 = cvt_pk_bf16(bbv.x, 0.f) << 16, bw1 = cvt_pk_bf16(bbv.y, 0.f) << 16;
                        ow[j0] = rq0 | bw0; ow[j1] = rq1 | bw1;
                        av[m][j0] = aa.x; av[m][j1] = aa.y; bv[m][j0] = __uint_as_float(bw0); bv[m][j1] = __uint_as_float(bw1);
                    }
                    *(u32x4*)(AB + (tok0 + m) * 1024 + c) = ow;
                }
#pragma unroll
                for (int mm = 0; mm < 4; ++mm) { const int m = d ? 3 - mm : mm;
#pragma unroll
                    for (int j = 0; j < 4; ++j) { St[j] = av[m][j] * St[j] + bv[m][j]; Pt[j] *= av[m][j]; } }
#pragma unroll
                for (int j = 0; j < 4; ++j) {
                    float P = Pt[j], S = St[j];
                    if (d == 0) {
                        { const float pe = dpp_get<0x111>(P), se = dpp_get<0x111>(S); S = P * se + S; P = P * pe; }
                        { const float pe = dpp_get<0x112>(P), se = dpp_get<0x112>(S); S = P * se + S; P = P * pe; }
                        { const float pe = dpp_get<0x114>(P), se = dpp_get<0x114>(S); S = P * se + S; P = P * pe; }
                        { const float pe = dpp_get<0x118>(P), se = dpp_get<0x118>(S); S = P * se + S; P = P * pe; }
                    } else {
                        { const float pe = dpp_get<0x101>(P), se = dpp_get<0x101>(S); S = P * se + S; P = P * pe; }
                        { const float pe = dpp_get<0x102>(P), se = dpp_get<0x102>(S); S = P * se + S; P = P * pe; }
                        { const float pe = dpp_get<0x104>(P), se = dpp_get<0x104>(S); S = P * se + S; P = P * pe; }
                        { const float pe = dpp_get<0x108>(P), se = dpp_get<0x108>(S); S = P * se + S; P = P * pe; }
                    }
                    Pt[j] = P; St[j] = S;
                }
                if (fr == (d ? 0 : 15)) { const size_t o = ((size_t)(bb * 2 + d) * 68 + seg * 4 + ai * 2 + wr) * 1024 + c; *(f32x4*)(Pp + o) = Pt; *(f32x4*)(Sp + o) = St; }
            }
        }
    }
};

struct EpiQup {
    static constexpr bool PERM = true; static constexpr int KHOOK = 0;
    unsigned char* ws; const float* rope;
    __device__ __forceinline__ void operator()(const AccT& acc, const pg8::Unit& u) const {
        EPI_LANES();
        const float* rs = (const float*)(ws + WS_RSQ); bf16_t* Q = (bf16_t*)(ws + WS_QM);
        const int seg = u.pm % PAN; const int row0 = u.pm * 256 + wr * 64 + fr;
        float sv[8];
#pragma unroll
        for (int q = 0; q < 8; ++q) sv[q] = rs[row0 + (q >> 2) * 128 + (q & 3) * 16];
#pragma unroll
        for (int ai = 0; ai < 2; ++ai)
#pragma unroll
        for (int mh = 0; mh < 2; ++mh) {
            f32x4 csv[2][2], snv[2][2];
#pragma unroll
            for (int mm = 0; mm < 2; ++mm)
#pragma unroll
                for (int bj = 0; bj < 2; ++bj) { const int j = (u.pn * 256 + bj * 128 + wc * 32 + 8 * fq) % 192; const bool rp = (j >= 128 && seg != 0);
                    const int pos = rp ? (seg - 1) * 256 + (wr * 64 + fr + ai * 128 + (mh * 2 + mm) * 16) : 0; const int pj = rp ? (j - 128) >> 1 : 0;
                    csv[mm][bj] = *(const f32x4*)(rope + (size_t)pos * 32 + pj); snv[mm][bj] = *(const f32x4*)(rope + (size_t)4096 * 32 + (size_t)pos * 32 + pj); }
            asm volatile("" ::: "memory");
#pragma unroll
            for (int mm = 0; mm < 2; ++mm) { const int m = mh * 2 + mm;
                const int r = row0 + ai * 128 + m * 16; const float s = sv[ai * 4 + m];
#pragma unroll
                for (int bj = 0; bj < 2; ++bj) {
                    const int c0 = u.pn * 256 + bj * 128 + wc * 32 + 8 * fq; const int j = c0 % 192;
                    f32x4 v0 = acc[ai][bj][m][0] * s, v1 = acc[ai][bj][m][1] * s;
                    if (j >= 128 && seg != 0) {
                        const f32x4 cs = csv[mm][bj];
                        const f32x4 sn = snv[mm][bj];
                        f32x4 o0, o1;
                        o0[0] = v0[0] * cs[0] - v0[1] * sn[0]; o0[1] = v0[0] * sn[0] + v0[1] * cs[0];
                        o0[2] = v0[2] * cs[1] - v0[3] * sn[1]; o0[3] = v0[2] * sn[1] + v0[3] * cs[1];
                        o1[0] = v1[0] * cs[2] - v1[1] * sn[2]; o1[1] = v1[0] * sn[2] + v1[1] * cs[2];
                        o1[2] = v1[2] * cs[3] - v1[3] * sn[3]; o1[3] = v1[2] * sn[3] + v1[3] * cs[3];
                        v0 = o0; v1 = o1;
                    }
                    *(u32x4*)(Q + (size_t)r * 1536 + c0) = pack8(v0, v1);
                }
            }
        }
    }
};

struct EpiKVup {
    static constexpr bool PERM = true; static constexpr int KHOOK = 0;
    unsigned char* ws;
    __device__ __forceinline__ void operator()(const AccT& acc, const pg8::Unit& u) const {
        EPI_LANES();
        const float* rs = (const float*)(ws + WS_RSKV); bf16_t* Kd = (bf16_t*)(ws + WS_KM); bf16_t* Vd = (bf16_t*)(ws + WS_VM);
        const int row0 = u.pm * 256 + wr * 64 + fr; const int cl = wc * 32 + 8 * fq;
        float sv[8];
#pragma unroll
        for (int q = 0; q < 8; ++q) sv[q] = rs[row0 + (q >> 2) * 128 + (q & 3) * 16];
        asm volatile("" ::: "memory");
#pragma unroll
        for (int ai = 0; ai < 2; ++ai)
#pragma unroll
            for (int m = 0; m < 4; ++m) {
                const size_t r = (size_t)(row0 + ai * 128 + m * 16); const float s = sv[ai * 4 + m];
                *(u32x4*)(Kd + r * 1536 + u.pn * 192 + cl) = pack8(acc[ai][0][m][0] * s, acc[ai][0][m][1] * s);
                *(u32x4*)(Vd + r * 1024 + u.pn * 128 + cl) = pack8(acc[ai][1][m][0] * s, acc[ai][1][m][1] * s);
            }
    }
};

__device__ __forceinline__ float gate_u8(unsigned w, int k) { return ((float)((w >> (8 * k)) & 0xffu) + 0.5f) * (1.f / 256.f); }
__device__ __forceinline__ f32x4 gate_u8x4(unsigned w) { return (f32x4){(float)(w & 0xffu), (float)((w >> 8) & 0xffu), (float)((w >> 16) & 0xffu), (float)(w >> 24)} * (1.f / 256.f) + (0.5f / 256.f); }
struct EpiMergeF {
    static constexpr bool PERM = true; static constexpr int KHOOK = 16;
    unsigned char* ws;
    __device__ __forceinline__ void khook(AccT& acc, const pg8::Unit& u, int i) const {
        EPI_LANES();
        const unsigned char* SG = ws + WS_SG + (i - 1) * 2048;
        const int row0 = u.pm * 256 + wr * 64 + fr;
#pragma unroll
        for (int ai = 0; ai < 2; ++ai) {
            u32x2 gpv[4][2], gnv[4][2];
#pragma unroll
            for (int m = 0; m < 4; ++m)
#pragma unroll
                for (int bj = 0; bj < 2; ++bj) { const size_t o = (size_t)(row0 + ai * 128 + m * 16) * 6144 + u.pn * 256 + bj * 128 + wc * 32 + 8 * fq;
                    gpv[m][bj] = *(const u32x2*)(SG + o); gnv[m][bj] = *(const u32x2*)(SG + o + 2048); }
            asm volatile("" ::: "memory");
#pragma unroll
            for (int m = 0; m < 4; ++m) {
#pragma unroll
                for (int bj = 0; bj < 2; ++bj) {
                    const u32x2 gp = gpv[m][bj], gn = gnv[m][bj];
#pragma unroll
                    for (int n = 0; n < 2; ++n) { const f32x4 nu = gate_u8x4(n ? gp.y : gp.x), de = gate_u8x4(n ? gn.y : gn.x);
                        acc[ai][bj][m][n] *= nu * (f32x4){__builtin_amdgcn_rcpf(de[0]), __builtin_amdgcn_rcpf(de[1]), __builtin_amdgcn_rcpf(de[2]), __builtin_amdgcn_rcpf(de[3])}; }
                }
            }
        }
    }
    __device__ __forceinline__ void operator()(const AccT& acc, const pg8::Unit& u) const {
        EPI_LANES();
        const unsigned char* SG = ws + WS_SG + 2 * 2048; bf16_t* YB = (bf16_t*)(ws + WS_YMB);
        const int row0 = u.pm * 256 + wr * 64 + fr;
        u32x2 gwv[2][4][2];
#pragma unroll
        for (int ai = 0; ai < 2; ++ai)
#pragma unroll
            for (int m = 0; m < 4; ++m)
#pragma unroll
                for (int bj = 0; bj < 2; ++bj) gwv[ai][m][bj] = *(const u32x2*)(SG + (size_t)(row0 + ai * 128 + m * 16) * 6144 + u.pn * 256 + bj * 128 + wc * 32 + 8 * fq);
        asm volatile("" ::: "memory");
#pragma unroll
        for (int ai = 0; ai < 2; ++ai)
#pragma unroll
            for (int m = 0; m < 4; ++m) {
                const size_t r = (size_t)(row0 + ai * 128 + m * 16);
#pragma unroll
                for (int bj = 0; bj < 2; ++bj) {
                    const int c0 = u.pn * 256 + bj * 128 + wc * 32 + 8 * fq;
                    const u32x2 gw = gwv[ai][m][bj];
                    const f32x4 g0 = gate_u8x4(gw.x), g1 = gate_u8x4(gw.y);
                    *(u32x4*)(YB + r * 2048 + c0) = pack8(acc[ai][bj][m][0] * g0, acc[ai][bj][m][1] * g1);
                }
            }
    }
};

struct EpiResid {
    static constexpr bool PERM = true; static constexpr int KHOOK = 0;
    unsigned char* ws; int goff;
    const float* gain; int scoff, nidx;
    __device__ __forceinline__ void operator()(const AccT& acc, const pg8::Unit& u) const {
        EPI_LANES();
        const int rl0 = wr * 64 + fr;
        if (u.split) {
            unsigned short* PT = (unsigned short*)(ws + WS_PART) + ((size_t)((u.pm / PAN) * 8 + u.pn) * KSPLIT + (u.split - 1)) * 65536;
#pragma unroll
            for (int ai = 0; ai < 2; ++ai)
#pragma unroll
                for (int m = 0; m < 4; ++m)
#pragma unroll
                    for (int bj = 0; bj < 2; ++bj) { const f32x4 v0 = acc[ai][bj][m][0], v1 = acc[ai][bj][m][1];
                        u32x4 w; w.x = pack_h2(v0[0], v0[1]); w.y = pack_h2(v0[2], v0[3]); w.z = pack_h2(v1[0], v1[1]); w.w = pack_h2(v1[2], v1[3]);
                        *(u32x4*)(PT + (size_t)(rl0 + ai * 128 + m * 16) * 256 + bj * 128 + wc * 32 + 8 * fq) = w; }
            return;
        }
        const int b = u.pm / PAN, seg = u.pm % PAN, mr = seg == 0 ? 4 : b;
        const float* gp = (const float*)(ws + WS_MOD) + goff + mr * 12288;
        unsigned short* XSp = (unsigned short*)(ws + WS_XS) + (size_t)u.pm * 256 * 2048; bf16_t* XG = (bf16_t*)(ws + WS_H) + (size_t)u.pm * 256 * 2048;
        f32x4 gv[2][2], Gv[2][2];
        const float* gainq = gain ? gain : gp; const float* scq = (const float*)(ws + WS_MOD) + (gain ? scoff : goff) + mr * 12288;
#pragma unroll
        for (int bj = 0; bj < 2; ++bj)
#pragma unroll
            for (int n = 0; n < 2; ++n) { const int c = u.pn * 256 + bj * 128 + wc * 32 + 8 * fq + 4 * n; gv[bj][n] = *(const f32x4*)(gp + c);
                Gv[bj][n] = *(const f32x4*)(gainq + c) * (*(const f32x4*)(scq + c) + 1.f); }
        float rsum[8];
        u32x4 xa[2][2], xb[2][2];
#define RQ_ROW(q, mm) ((size_t)(rl0 + ((q) >> 1) * 128 + (((q) & 1) * 2 + (mm)) * 16) * 2048 + u.pn * 256 + wc * 32 + 8 * fq)
#define RQ_LD(buf, q) do { _Pragma("unroll") for (int mm = 0; mm < 2; ++mm) _Pragma("unroll") for (int bj = 0; bj < 2; ++bj) buf[mm][bj] = *(const u32x4*)(XSp + RQ_ROW(q, mm) + bj * 128); asm volatile("" ::: "memory"); } while (0)
#define RQ_DO(buf, q) do { _Pragma("unroll") for (int mm = 0; mm < 2; ++mm) { const int ai = (q) >> 1, m = ((q) & 1) * 2 + mm; const size_t ro = RQ_ROW(q, mm); float ss = 0.f; \
            _Pragma("unroll") for (int bj = 0; bj < 2; ++bj) { const u32x4 xo = buf[mm][bj]; \
                const f32x4 x0 = (f32x4){h2lo(xo.x), h2hi(xo.x), h2lo(xo.y), h2hi(xo.y)} + gv[bj][0] * acc[ai][bj][m][0], x1 = (f32x4){h2lo(xo.z), h2hi(xo.z), h2lo(xo.w), h2hi(xo.w)} + gv[bj][1] * acc[ai][bj][m][1]; \
                u32x4 w; w.x = pack_h2(x0[0], x0[1]); w.y = pack_h2(x0[2], x0[3]); w.z = pack_h2(x1[0], x1[1]); w.w = pack_h2(x1[2], x1[3]); \
                *(u32x4*)(XSp + ro + bj * 128) = w; \
                if (gain) { const f32x4 y0 = x0 * Gv[bj][0], y1 = x1 * Gv[bj][1]; \
                    u32x4 yw; yw.x = cvt_pk_bf16(y0[0], y0[1]); yw.y = cvt_pk_bf16(y0[2], y0[3]); yw.z = cvt_pk_bf16(y1[0], y1[1]); yw.w = cvt_pk_bf16(y1[2], y1[3]); \
                    *(u32x4*)(XG + ro + bj * 128) = yw; \
                    const f32x4 q_ = x0 * x0 + x1 * x1; ss += (q_[0] + q_[1]) + (q_[2] + q_[3]); } } \
            rsum[ai * 4 + m] = ss; } asm volatile("" ::: "memory"); } while (0)
        RQ_LD(xa, 0); RQ_LD(xb, 1); RQ_DO(xa, 0); RQ_LD(xa, 2); RQ_DO(xb, 1); RQ_LD(xb, 3); RQ_DO(xa, 2); RQ_DO(xb, 3);
#undef RQ_ROW
#undef RQ_LD
#undef RQ_DO
        if (gain) {
#pragma unroll
            for (int j = 0; j < 8; ++j) { float v = rsum[j]; v += __shfl_xor(v, 16); v += __shfl_xor(v, 32); rsum[j] = v; }
            unsigned long long* SQ = (unsigned long long*)(ws + WS_SSQ) + (size_t)nidx * TT + (size_t)u.pm * 256 + rl0;
#pragma unroll
            for (int h = 0; h < 2; ++h) {
                const float v = fq == 0 ? rsum[h * 4] : fq == 1 ? rsum[h * 4 + 1] : fq == 2 ? rsum[h * 4 + 2] : rsum[h * 4 + 3];
                atomicAdd(SQ + h * 128 + fq * 16, __float2ull_rn(v * 16777216.f));
            }
        }
    }
};

__device__ __forceinline__ float dpp_ror1(float src) { return __int_as_float(__builtin_amdgcn_update_dpp(0, __float_as_int(src), 0x121, 0xf, 0xf, false)); }
__device__ __forceinline__ float dpp_ror15(float src) { return __int_as_float(__builtin_amdgcn_update_dpp(0, __float_as_int(src), 0x12F, 0xf, 0xf, false)); }
struct EpiFfnUp {
    static constexpr bool PERM = true; static constexpr int KHOOK = 0; static constexpr bool APERM = true; static constexpr bool PREF = true; static constexpr bool CTXWAIT = true;
    __device__ __forceinline__ void ctx_wait() const { rsc.ctx_wait(); }
    unsigned char* ws; const float* cw; const float* cb; char* lds; RowScale rsc;
    __device__ __forceinline__ void prefetch(LAS unsigned char* l, const pg8::Unit& u, int wid, int lane) const { rsc.prefetch(l, u, wid, lane);
        const int t = wid & 3; const float* src = (t < 3 ? cw + (size_t)t * DFF2 : cb) + (wid >> 2) * DFF + u.pn * 128 + lane;
        LAS unsigned char* d = l + LDS_CW + u.par * 4096 + wid * 512;
        __builtin_amdgcn_global_load_lds((const unsigned*)src, (LAS unsigned*)d, 4, 0, 0); __builtin_amdgcn_global_load_lds((const unsigned*)(src + 64), (LAS unsigned*)(d + 256), 4, 0, 0); }
    __device__ __forceinline__ void operator()(AccT& acc, const pg8::Unit& u) const {
        EPI_LANES();
        rsc.apply(acc, u, lds, wr, wc, fr, fq);
        float* EX = (float*)(lds + LDS_EXCH);
        const int jb = u.pn * 128 + wc * 32 + 8 * fq;
        if (fr == 0 || fr == 15) {
            const int m = fr == 0 ? 0 : 3, which = fr == 0 ? 0 : 1;
#pragma unroll
            for (int ai = 0; ai < 2; ++ai)
#pragma unroll
                for (int bj = 0; bj < 2; ++bj)
#pragma unroll
                    for (int n = 0; n < 2; ++n) *(f32x4*)(EX + (((ai * 2 + wr) * 2 + which) * 4 + wc) * 64 + ((bj * 4 + fq) * 2 + n) * 4) = acc[ai][bj][m][n];
        }
        {
            float* HL = (float*)(ws + WS_HALO) + (size_t)u.pm * 4 * DFF2;
            if (wr == 0 && fr == 0) {
#pragma unroll
                for (int m = 0; m < 2; ++m)
#pragma unroll
                    for (int n = 0; n < 2; ++n) { *(f32x4*)(HL + (size_t)m * DFF2 + jb + 4 * n) = acc[0][0][m][n]; *(f32x4*)(HL + (size_t)m * DFF2 + DFF + jb + 4 * n) = acc[0][1][m][n]; }
            }
            if (wr == 1 && fr == 15) {
#pragma unroll
                for (int m = 2; m < 4; ++m)
#pragma unroll
                    for (int n = 0; n < 2; ++n) { *(f32x4*)(HL + (size_t)m * DFF2 + jb + 4 * n) = acc[1][0][m][n]; *(f32x4*)(HL + (size_t)m * DFF2 + DFF + jb + 4 * n) = acc[1][1][m][n]; }
            }
        }
        asm volatile("s_waitcnt lgkmcnt(0)" ::: "memory");
        __builtin_amdgcn_s_barrier();
        __builtin_amdgcn_s_barrier();
        asm volatile("" ::: "memory");
        bf16_t* ACT = (bf16_t*)(ws + WS_ACT);
        const int row0 = u.pm * 256 + wr * 64 + 4 * fr;
#pragma unroll
        for (int ai = 0; ai < 2; ++ai) {
            const int blk = ai * 2 + wr;
            u32x2 outw[4][2];
#pragma unroll
            for (int n = 0; n < 2; ++n) {
                f32x4 w0v, w1v, w2v, bv, w0g, w1g, w2g, bg;
                { const float* cl = (const float*)(lds + LDS_CW + u.par * 4096) + wc * 32 + 8 * fq + 4 * n;
                  w0v = *(const f32x4*)(cl); w1v = *(const f32x4*)(cl + 128); w2v = *(const f32x4*)(cl + 256); bv = *(const f32x4*)(cl + 384);
                  w0g = *(const f32x4*)(cl + 512); w1g = *(const f32x4*)(cl + 640); w2g = *(const f32x4*)(cl + 768); bg = *(const f32x4*)(cl + 896); }
                f32x4 tv = {0.f, 0.f, 0.f, 0.f}, tg = tv, bvh = tv, bgh = tv;
                if (blk > 0) { const float* e = EX + ((((blk - 1) * 2 + 1) * 4 + wc) * 64); tv = *(const f32x4*)(e + ((0 * 4 + fq) * 2 + n) * 4); tg = *(const f32x4*)(e + ((1 * 4 + fq) * 2 + n) * 4); }
                if (blk < 3) { const float* e = EX + ((((blk + 1) * 2 + 0) * 4 + wc) * 64); bvh = *(const f32x4*)(e + ((0 * 4 + fq) * 2 + n) * 4); bgh = *(const f32x4*)(e + ((1 * 4 + fq) * 2 + n) * 4); }
                f32x4 pv0, pg0, nv3, ng3;
#pragma unroll
                for (int j = 0; j < 4; ++j) {
                    pv0[j] = dpp_shr1(tv[j], acc[ai][0][3][n][j]); pg0[j] = dpp_shr1(tg[j], acc[ai][1][3][n][j]);
                    nv3[j] = dpp_shl1(bvh[j], acc[ai][0][0][n][j]); ng3[j] = dpp_shl1(bgh[j], acc[ai][1][0][n][j]);
                }
#pragma unroll
                for (int m = 0; m < 4; ++m) {
                    const f32x4 pv4 = m == 0 ? pv0 : acc[ai][0][m - 1 < 0 ? 0 : m - 1][n], pg4 = m == 0 ? pg0 : acc[ai][1][m - 1 < 0 ? 0 : m - 1][n];
                    const f32x4 nv4 = m == 3 ? nv3 : acc[ai][0][m + 1 > 3 ? 3 : m + 1][n], ng4 = m == 3 ? ng3 : acc[ai][1][m + 1 > 3 ? 3 : m + 1][n];
                    const f32x4 uv = bv + w0v * pv4 + w1v * acc[ai][0][m][n] + w2v * nv4;
                    const f32x4 ug = bg + w0g * pg4 + w1g * acc[ai][1][m][n] + w2g * ng4;
                    const f32x4 tt = ug * (-1.4426950408889634f);
                    const f32x4 dd = (f32x4){__builtin_amdgcn_exp2f(tt[0]), __builtin_amdgcn_exp2f(tt[1]), __builtin_amdgcn_exp2f(tt[2]), __builtin_amdgcn_exp2f(tt[3])} + 1.f;
                    const f32x4 o = (ug * uv) * (f32x4){__builtin_amdgcn_rcpf(dd[0]), __builtin_amdgcn_rcpf(dd[1]), __builtin_amdgcn_rcpf(dd[2]), __builtin_amdgcn_rcpf(dd[3])};
                    outw[m][n].x = cvt_pk_bf16(o[0], o[1]); outw[m][n].y = cvt_pk_bf16(o[2], o[3]);
                }
            }
#pragma unroll
            for (int m = 0; m < 4; ++m) { u32x4 w; w.x = outw[m][0].x; w.y = outw[m][0].y; w.z = outw[m][1].x; w.w = outw[m][1].y;
                *(u32x4*)(ACT + (size_t)(row0 + ai * 128 + m) * DFF + jb) = w; }
        }
    }
};

struct EpiStoreBf16 {
    static constexpr bool PERM = true; static constexpr int KHOOK = 0;
    bf16_t* O; int ld;
    __device__ __forceinline__ void operator()(const AccT& acc, const pg8::Unit& u) const {
        EPI_LANES();
        const int row0 = u.pm * 256 + wr * 64 + fr;
#pragma unroll
        for (int ai = 0; ai < 2; ++ai)
#pragma unroll
            for (int m = 0; m < 4; ++m) {
                bf16_t* rp = O + (size_t)(row0 + ai * 128 + m * 16) * ld + u.pn * 256 + wc * 32 + 8 * fq;
#pragma unroll
                for (int bj = 0; bj < 2; ++bj) *(u32x4*)(rp + bj * 128) = pack8(acc[ai][bj][m][0], acc[ai][bj][m][1]);
            }
    }
};

#define SBAR() __builtin_amdgcn_sched_barrier(0)
__device__ __forceinline__ int crow(int r, int hi) { return (r & 3) + 8 * (r >> 2) + 4 * hi; }
constexpr float ATT_THR = 8.f;
template <int DQK> struct AttC { static constexpr float SCALE = (DQK == 128) ? 0.08838834764831845f : 0.07216878364870323f; static constexpr int KROWB = (DQK == 128) ? 256 : 512; };
__device__ __forceinline__ int kswz(int row) { return ((row & 7) | ((row >> 1) & 8)) << 4; }

template <int DQK>
__device__ __forceinline__ void partialSM(f32x16& p0, f32x16& p1, float& m_reg, float& mn, float& alpha) {
    constexpr float SCALE = AttC<DQK>::SCALE; constexpr float C = SCALE * 1.4426950408889634f;
    float pmax = p0[0];
#pragma unroll
    for (int r = 1; r < 16; ++r) pmax = fmaxf(pmax, p0[r]);
#pragma unroll
    for (int r = 0; r < 16; ++r) pmax = fmaxf(pmax, p1[r]);
    { auto rr = __builtin_amdgcn_permlane32_swap(__float_as_uint(pmax), __float_as_uint(pmax), false, false);
      pmax = fmaxf(__uint_as_float(rr[0]), __uint_as_float(rr[1])); }
    if (__builtin_expect(__all(pmax - m_reg <= ATT_THR / SCALE), 1)) { mn = m_reg; alpha = 1.f; }
    else { mn = fmaxf(m_reg, pmax); alpha = __builtin_amdgcn_exp2f((m_reg - mn) * C); m_reg = mn; }
    const float mnC = -mn * C;
#pragma unroll
    for (int r = 0; r < 16; ++r) p0[r] = fmaf(p0[r], C, mnC);
#pragma unroll
    for (int r = 0; r < 16; ++r) p1[r] = fmaf(p1[r], C, mnC);
#pragma unroll
    for (int r = 0; r < 16; ++r) p0[r] = __builtin_amdgcn_exp2f(p0[r]);
}
__device__ __forceinline__ void finishSM(f32x16& p0, f32x16& p1, float alpha, float& l_reg, bf16x8& pa0, bf16x8& pa1, bf16x8& pa2, bf16x8& pa3) {
#pragma unroll
    for (int r = 0; r < 16; ++r) p1[r] = __builtin_amdgcn_exp2f(p1[r]);
    float ps = 0;
#pragma unroll
    for (int r = 0; r < 16; ++r) ps += p0[r];
#pragma unroll
    for (int r = 0; r < 16; ++r) ps += p1[r];
    { auto rr = __builtin_amdgcn_permlane32_swap(__float_as_uint(ps), __float_as_uint(ps), false, false);
      ps = __uint_as_float(rr[0]) + __uint_as_float(rr[1]); }
    l_reg = l_reg * alpha + ps;
#define PK4(P, BASE, OUT) do { unsigned a0 = cvt_pk_bf16(P[BASE + 0], P[BASE + 1]), a1 = cvt_pk_bf16(P[BASE + 2], P[BASE + 3]);   \
    unsigned b0 = cvt_pk_bf16(P[BASE + 4], P[BASE + 5]), b1 = cvt_pk_bf16(P[BASE + 6], P[BASE + 7]);                              \
    auto r0 = __builtin_amdgcn_permlane32_swap(a0, b0, false, false); auto r1 = __builtin_amdgcn_permlane32_swap(a1, b1, false, false); \
    u32x4 w = {r0[0], r1[0], r0[1], r1[1]}; OUT = *reinterpret_cast<bf16x8*>(&w); } while (0)
    PK4(p0, 0, pa0); PK4(p0, 8, pa1); PK4(p1, 0, pa2); PK4(p1, 8, pa3);
#undef PK4
}
template <int DQK, int QL = 0>
__device__ __forceinline__ void qkt(f32x16& p0, f32x16& p1, const char* Ks, const bf16x8* qr, int r32, int hi, const char* Ql = nullptr) {
    constexpr int KROWB = AttC<DQK>::KROWB, ND = DQK / 16;
    p0 = f32x16{}; p1 = f32x16{};
#pragma unroll
    for (int d0 = 0; d0 < ND; ++d0) { const int cb = (d0 * 16 + hi * 8) * 2;
        const bf16x8 b0 = *reinterpret_cast<const bf16x8*>(Ks + r32 * KROWB + (cb ^ kswz(r32)));
        const bf16x8 b1 = *reinterpret_cast<const bf16x8*>(Ks + (32 + r32) * KROWB + (cb ^ kswz(r32)));
        bf16x8 qv;
        if (d0 < ND - QL) qv = qr[d0]; else qv = *reinterpret_cast<const bf16x8*>(Ql + ((((d0 - (ND - QL)) * 2 + hi) ^ ((r32 >> 1) & 7)) << 4));
        p0 = __builtin_amdgcn_mfma_f32_32x32x16_bf16(b0, qv, p0, 0, 0, 0);
        p1 = __builtin_amdgcn_mfma_f32_32x32x16_bf16(b1, qv, p1, 0, 0, 0); }
}
__device__ __forceinline__ int v_st(int k, int c) { const int kk = (k & ~0xC) | ((k & 4) << 1) | ((k & 8) >> 1); return ((kk >> 3) * 4 + (c >> 5)) * 512 + ((kk & 7) * 32 + (c & 31)) * 2; }
__device__ __forceinline__ int v_rd_base(int lane) { return ((lane & 3) << 3) | (((lane >> 2) & 3) << 6) | (((lane >> 4) & 1) << 5) | (((lane >> 5) & 1) << 8); }
constexpr int v_rd_off(int d0, int ks, int half) { return d0 * 512 + ks * 4096 + half * 2048; }
template <int OFF> __device__ __forceinline__ s16x4 tr_read(int vb) {
    s16x4 r; asm volatile("ds_read_b64_tr_b16 %0, %1 offset:%2" : "=&v"(r) : "v"(vb), "i"(OFF) : "memory"); return r;
}
template <int D0> __device__ __forceinline__ void pv_one(f32x16& od, int vb, bf16x8 pa0, bf16x8 pa1, bf16x8 pa2, bf16x8 pa3) {
    const s16x4 l0 = tr_read<v_rd_off(D0, 0, 0)>(vb), h0 = tr_read<v_rd_off(D0, 0, 1)>(vb), l1 = tr_read<v_rd_off(D0, 1, 0)>(vb), h1 = tr_read<v_rd_off(D0, 1, 1)>(vb);
    const s16x4 l2 = tr_read<v_rd_off(D0, 2, 0)>(vb), h2 = tr_read<v_rd_off(D0, 2, 1)>(vb), l3 = tr_read<v_rd_off(D0, 3, 0)>(vb), h3 = tr_read<v_rd_off(D0, 3, 1)>(vb);
    asm volatile("s_waitcnt lgkmcnt(0)" ::: "memory"); SBAR();
#define PKV(L, H) (bf16x8){L[0], L[1], L[2], L[3], H[0], H[1], H[2], H[3]}
    od = __builtin_amdgcn_mfma_f32_32x32x16_bf16(pa0, PKV(l0, h0), od, 0, 0, 0);
    od = __builtin_amdgcn_mfma_f32_32x32x16_bf16(pa1, PKV(l1, h1), od, 0, 0, 0);
    od = __builtin_amdgcn_mfma_f32_32x32x16_bf16(pa2, PKV(l2, h2), od, 0, 0, 0);
    od = __builtin_amdgcn_mfma_f32_32x32x16_bf16(pa3, PKV(l3, h3), od, 0, 0, 0);
#undef PKV
}
__device__ __forceinline__ void pv_d0(f32x16* o, int vb, bf16x8 pa0, bf16x8 pa1, bf16x8 pa2, bf16x8 pa3) {
    pv_one<0>(o[0], vb, pa0, pa1, pa2, pa3); pv_one<1>(o[1], vb, pa0, pa1, pa2, pa3); pv_one<2>(o[2], vb, pa0, pa1, pa2, pa3); pv_one<3>(o[3], vb, pa0, pa1, pa2, pa3);
}

template <int DQK>
__device__ __forceinline__ void qkt_p(f32x16& p0, f32x16& p1, const char* Ks, const bf16x8* qr, int r32, int hi) {
    constexpr int KROWB = AttC<DQK>::KROWB, ND = DQK / 16;
    const char* k0 = Ks + r32 * KROWB; const char* k1 = Ks + (32 + r32) * KROWB; const int sw = kswz(r32), hb = hi * 16;
    bf16x8 fa[3], fb[3];
#define QK_RD(d0, s) do { fa[s] = *reinterpret_cast<const bf16x8*>(k0 + (((d0) * 32 + hb) ^ sw)); fb[s] = *reinterpret_cast<const bf16x8*>(k1 + (((d0) * 32 + hb) ^ sw)); } while (0)
    QK_RD(0, 0); QK_RD(1, 1); SBAR();
    p0 = f32x16{}; p1 = f32x16{};
#pragma unroll
    for (int d0 = 0; d0 < ND; ++d0) {
        if (d0 + 2 < ND) QK_RD(d0 + 2, (d0 + 2) % 3);
        p0 = __builtin_amdgcn_mfma_f32_32x32x16_bf16(fa[d0 % 3], qr[d0], p0, 0, 0, 0);
        p1 = __builtin_amdgcn_mfma_f32_32x32x16_bf16(fb[d0 % 3], qr[d0], p1, 0, 0, 0);
        SBAR();
    }
#undef QK_RD
}
template <int KS> __device__ __forceinline__ void pv_ld(s16x4 (&l)[4], s16x4 (&h)[4], int vb) {
    l[0] = tr_read<v_rd_off(0, KS, 0)>(vb); h[0] = tr_read<v_rd_off(0, KS, 1)>(vb); l[1] = tr_read<v_rd_off(1, KS, 0)>(vb); h[1] = tr_read<v_rd_off(1, KS, 1)>(vb);
    l[2] = tr_read<v_rd_off(2, KS, 0)>(vb); h[2] = tr_read<v_rd_off(2, KS, 1)>(vb); l[3] = tr_read<v_rd_off(3, KS, 0)>(vb); h[3] = tr_read<v_rd_off(3, KS, 1)>(vb);
}
__device__ __forceinline__ void pv_mm(f32x16* o, bf16x8 pa, const s16x4 (&l)[4], const s16x4 (&h)[4]) {
#define PKV(L, H) (bf16x8){L[0], L[1], L[2], L[3], H[0], H[1], H[2], H[3]}
#pragma unroll
    for (int d = 0; d < 4; ++d) o[d] = __builtin_amdgcn_mfma_f32_32x32x16_bf16(pa, PKV(l[d], h[d]), o[d], 0, 0, 0);
#undef PKV
}
__device__ __forceinline__ void pv_il(f32x16* o, int vb, bf16x8 pa0, bf16x8 pa1, bf16x8 pa2, bf16x8 pa3) {
    s16x4 la[4], ha[4], lb[4], hb[4];
    pv_ld<0>(la, ha, vb);
    asm volatile("s_waitcnt lgkmcnt(0)" ::: "memory"); SBAR();
    pv_ld<1>(lb, hb, vb); pv_mm(o, pa0, la, ha);
    asm volatile("s_waitcnt lgkmcnt(0)" ::: "memory"); SBAR();
    pv_ld<2>(la, ha, vb); pv_mm(o, pa1, lb, hb);
    asm volatile("s_waitcnt lgkmcnt(0)" ::: "memory"); SBAR();
    pv_ld<3>(lb, hb, vb); pv_mm(o, pa2, la, ha);
    asm volatile("s_waitcnt lgkmcnt(0)" ::: "memory"); SBAR();
    pv_mm(o, pa3, lb, hb); SBAR();
}

struct AttnArgs {
    const bf16_t* Q; int ldq; const bf16_t* K; int ldk; const bf16_t* V; int ldv; bf16_t* O; int ldo;
    int ntiles; int kbase;
    int ctxbase, latbase, kstart;
    int rg;
};
template <int MODE> __device__ __forceinline__ int tile_row(const AttnArgs& a, int j) {
    if (MODE == 0) return a.kbase + 64 * j;
    return j < 4 ? a.ctxbase + 64 * j : a.latbase + 64 * (a.kstart + j - 4);
}
__device__ __forceinline__ void na_mod(f32x16& p0, f32x16& p1, int j, int kstart, int rq, int cq, const float* tab, int hi) {
    if (j < 4) return;
    const int kr = kstart + j - 4; const int krs = min(max(rq - 4, 0), 56); const int cs = min(max(cq - 8, 0), 48);
    const bool rowok = (unsigned)(kr - krs) < 8u;
    const int tb = (kr - rq + 7) * 31 + 15 - cq;
#pragma unroll
    for (int r = 0; r < 16; ++r) {
        const int kc = crow(r, hi);
        const bool ok0 = rowok && ((unsigned)(kc - cs) < 16u), ok1 = rowok && ((unsigned)(kc + 32 - cs) < 16u);
        const float b0 = tab[ok0 ? tb + kc : 0], b1 = tab[ok1 ? tb + kc + 32 : 0];
        p0[r] = ok0 ? p0[r] + b0 : -1e30f; p1[r] = ok1 ? p1[r] + b1 : -1e30f;
    }
}

constexpr int NA_TABP = 576;
__device__ __forceinline__ void na_mod2(f32x16& p0, f32x16& p1, const float* t, unsigned okm) {
    asm volatile("" : "+v"(okm));
#pragma unroll
    for (int r = 0; r < 16; ++r) {
        const int kc0 = (r & 3) + 8 * (r >> 2);
        const float x0 = p0[r] + t[kc0], x1 = p1[r] + t[kc0 + 32];
        const unsigned m0 = (unsigned)__builtin_amdgcn_sbfe((int)okm, r, 1), m1 = (unsigned)__builtin_amdgcn_sbfe((int)okm, 16 + r, 1);
        p0[r] = __uint_as_float((__float_as_uint(x0) & m0) | (0xf149f2cau & ~m0)); p1[r] = __uint_as_float((__float_as_uint(x1) & m1) | (0xf149f2cau & ~m1));
    }
}

template <int DQK, int MODE, int SDEPTH, int LDQ, int LDK, int LDV, int LDO, int QL = 0>
__device__ __forceinline__ void attn_body(const AttnArgs& a, char* lds, const float* tab) {
    constexpr int KCH = DQK / 64, KROWB = AttC<DQK>::KROWB, SHM_K = 64 * KROWB, SHM_V = 64 * 128 * 2, ND = DQK / 16, KC8 = DQK / 8;
    int tid = threadIdx.x; asm volatile("" : "+v"(tid));
    const int wid = __builtin_amdgcn_readfirstlane(tid >> 6), lane = tid & 63, r32 = lane & 31, hi = lane >> 5;
    char* V_lds = lds; char* K_lds = lds + 2 * SHM_V;
    float* wsf = (float*)(lds + 2 * SHM_V + 2 * SHM_K) + wid * 64; float* li_l = wsf; float* al_l = wsf + 32;
    float m_reg = -1e30f, l_reg = 0; f32x16 o[4] = {}; bf16x8 qr[ND - QL];
    { const char* Qw = (const char*)a.Q + (size_t)(wid * 32) * LDQ * 2; const unsigned qo = (unsigned)(r32 * LDQ + hi * 8) * 2u;
#pragma unroll
      for (int d0 = 0; d0 < ND - QL; ++d0) qr[d0] = *reinterpret_cast<const bf16x8*>(Qw + qo + d0 * 32); }
    char* Q_lds = lds + 2 * SHM_V + 2 * SHM_K + 2048;
    const char* Ql = Q_lds + (wid * 32 + r32) * (QL * 32);
    if (QL > 0) {
        static_assert(QL == 0 || QL == 4, "Q tail image is written for 128-byte rows");
#pragma unroll
        for (int i = 0; i < (256 * QL * 2) / 512; ++i) { const int cid = tid + 512 * i; const int row = cid / (QL * 2), ch = cid % (QL * 2);
            *(bf16x8*)(Q_lds + row * (QL * 32) + ((ch ^ ((row >> 1) & 7)) << 4)) = *reinterpret_cast<const bf16x8*>((const char*)a.Q + ((size_t)row * LDQ + (ND - QL) * 16 + ch * 8) * 2); }
    }
    const int rq = a.rg * 4 + (wid >> 1), cq = (wid & 1) * 32 + r32;
    const int sr = tid >> 4, sc = (tid & 15) * 8, vst0 = v_st(sr, sc), vst1 = v_st(32 + sr, sc);
    const unsigned voff = (unsigned)(sr * LDV + sc) * 2u;
    unsigned koff[KCH]; int kdst[KCH];
#pragma unroll
    for (int i = 0; i < KCH; ++i) { const int cid = tid + 512 * i; const int kr_ = cid / KC8, kc_ = (cid % KC8) * 8; koff[i] = (unsigned)(kr_ * LDK + kc_) * 2u; kdst[i] = kr_ * KROWB + ((kc_ * 2) ^ kswz(kr_)); }
    const int vb0 = (int)(uintptr_t)V_lds + v_rd_base(lane);
    struct { bf16x8 vs0, vs1; bf16x8 ks[KCH]; } sr_[SDEPTH];
#define SLOAD(i, j) do { const int _t0 = tile_row<MODE>(a, (j)); const char* _vb = (const char*)a.V + (size_t)_t0 * (LDV * 2); const char* _kb = (const char*)a.K + (size_t)_t0 * (LDK * 2); \
    sr_[i].vs0 = *reinterpret_cast<const bf16x8*>(_vb + voff); sr_[i].vs1 = *reinterpret_cast<const bf16x8*>(_vb + voff + 32 * LDV * 2); \
    _Pragma("unroll") for (int _k = 0; _k < KCH; ++_k) sr_[i].ks[_k] = *reinterpret_cast<const bf16x8*>(_kb + koff[_k]); } while (0)
#define SWRITE(b, i) do { *(bf16x8*)(V_lds + (b) * SHM_V + vst0) = sr_[i].vs0; *(bf16x8*)(V_lds + (b) * SHM_V + vst1) = sr_[i].vs1; \
    _Pragma("unroll") for (int _k = 0; _k < KCH; ++_k) *(bf16x8*)(K_lds + (b) * SHM_K + kdst[_k]) = sr_[i].ks[_k]; } while (0)
#define SWAIT() do { if constexpr (SDEPTH == 2) { if constexpr (KCH == 2) asm volatile("s_waitcnt vmcnt(4)" ::: "memory"); else asm volatile("s_waitcnt vmcnt(5)" ::: "memory"); } else asm volatile("s_waitcnt vmcnt(0)" ::: "memory"); } while (0)
#define RESC(al) do { if (__any((al) < 1.f)) { if (hi == 0) al_l[r32] = (al); asm volatile("s_waitcnt lgkmcnt(0)" ::: "memory"); \
    _Pragma("unroll") for (int d = 0; d < 4; ++d) _Pragma("unroll") for (int r = 0; r < 16; ++r) o[d][r] *= al_l[crow(r, hi)]; } } while (0)
#define AMOD(P0, P1, j) do { if (MODE == 1) na_mod(P0, P1, (j), a.kstart, rq, cq, tab, hi); } while (0)
    f32x16 pA0, pA1, pB0, pB1; float mnA, mnB, alA, alB; bf16x8 pa0, pa1, pa2, pa3; const int NT = a.ntiles;
    constexpr int SE = 0, SO = SDEPTH - 1;
    SLOAD(SE, 0); asm volatile("s_waitcnt vmcnt(0)" ::: "memory"); SWRITE(0, SE); __syncthreads();
    const int krs_ = min(max(rq - 4, 0), 56);
#define TV(j) ((MODE == 0) || (j) < 4 || ((unsigned)(a.kstart + (j) - 4 - krs_) < 8u))
#define PFILL(P0, P1) do { _Pragma("unroll") for (int _r = 0; _r < 16; ++_r) { P0[_r] = -1e30f; P1[_r] = -1e30f; } } while (0)
    bool vA = true, vB = true;
    qkt<DQK, QL>(pA0, pA1, K_lds, qr, r32, hi, Ql); AMOD(pA0, pA1, 0); partialSM<DQK>(pA0, pA1, m_reg, mnA, alA);
    SLOAD(SO, 1); if constexpr (SDEPTH == 2) { if (2 < NT) SLOAD(SE, 2); }
    SWAIT(); SWRITE(1, SO); __syncthreads();
#pragma unroll 1
    for (int j = 1; j + 1 < NT; j += 2) {
        vB = TV(j);
        SBAR(); if (vB) { qkt<DQK, QL>(pB0, pB1, K_lds + SHM_K, qr, r32, hi, Ql); AMOD(pB0, pB1, j); } else { PFILL(pB0, pB1); }
        finishSM(pA0, pA1, alA, l_reg, pa0, pa1, pa2, pa3); SBAR();
        SLOAD(SO, j + SDEPTH); SBAR();
        if (vA) pv_d0(o, vb0, pa0, pa1, pa2, pa3);
        partialSM<DQK>(pB0, pB1, m_reg, mnB, alB);
        __syncthreads(); SWAIT(); SWRITE(0, SE);
        RESC(alB); __syncthreads();
        vA = TV(j + 1);
        SBAR(); if (vA) { qkt<DQK, QL>(pA0, pA1, K_lds, qr, r32, hi, Ql); AMOD(pA0, pA1, j + 1); } else { PFILL(pA0, pA1); }
        finishSM(pB0, pB1, alB, l_reg, pa0, pa1, pa2, pa3); SBAR();
        if (SDEPTH == 1 || j + 3 < NT) SLOAD(SE, j + 1 + SDEPTH); SBAR();
        if (vB) pv_d0(o, vb0 + SHM_V, pa0, pa1, pa2, pa3);
        partialSM<DQK>(pA0, pA1, m_reg, mnA, alA);
        __syncthreads(); SWAIT(); SWRITE(1, SO);
        RESC(alA); __syncthreads();
    }
    vB = TV(NT - 1);
    SBAR(); if (vB) { qkt<DQK, QL>(pB0, pB1, K_lds + SHM_K, qr, r32, hi, Ql); AMOD(pB0, pB1, NT - 1); } else { PFILL(pB0, pB1); }
    finishSM(pA0, pA1, alA, l_reg, pa0, pa1, pa2, pa3); SBAR();
    if (vA) pv_d0(o, vb0, pa0, pa1, pa2, pa3);
    partialSM<DQK>(pB0, pB1, m_reg, mnB, alB);
    __syncthreads(); RESC(alB);
    finishSM(pB0, pB1, alB, l_reg, pa0, pa1, pa2, pa3); SBAR();
    if (vB) pv_d0(o, vb0 + SHM_V, pa0, pa1, pa2, pa3);
#undef TV
#undef PFILL
    if (hi == 0) li_l[r32] = l_reg; asm volatile("s_waitcnt lgkmcnt(0)" ::: "memory");
    float rli[16];
#pragma unroll
    for (int r = 0; r < 16; ++r) rli[r] = __builtin_amdgcn_rcpf(li_l[crow(r, hi)]);
    int tz = threadIdx.x; asm volatile("" : "+v"(tz));
    bf16_t* Ow = a.O + (size_t)(__builtin_amdgcn_readfirstlane(tz >> 6) * 32) * LDO + (tz & 31);
    const int hz = (tz >> 5) & 1;
#pragma unroll
    for (int r = 0; r < 16; ++r) { const int orow = crow(r, hz);
#pragma unroll
        for (int d0 = 0; d0 < 4; ++d0) Ow[(size_t)orow * LDO + d0 * 32] = f2bf(o[d0][r] * rli[r]); }
    __syncthreads();
#undef SLOAD
#undef SWRITE
#undef SWAIT
#undef RESC
#undef AMOD
}

template <int MODE, int LDQ, int LDK, int LDV, int LDO>
__device__ __forceinline__ void attn_body_dma(const AttnArgs& a, char* lds, const float* tab) {
    constexpr int DQK = 128, ND = 8, RING = 32768;
    int tid = threadIdx.x; asm volatile("" : "+v"(tid));
    const int wid = __builtin_amdgcn_readfirstlane(tid >> 6), lane = tid & 63, r32 = lane & 31, hi = lane >> 5;
    LAS unsigned char* ldsl = (LAS unsigned char*)lds + wid * 2048;
    float* wsf = (float*)(lds + LDS_EXCH) + wid * 64; float* li_l = wsf; float* al_l = wsf + 32;
    float m_reg = -1e30f, l_reg = 0; f32x16 o[4] = {}; bf16x8 qr[ND];
    { const char* Qw = (const char*)a.Q + (size_t)(wid * 32) * LDQ * 2; const unsigned qo = (unsigned)(r32 * LDQ + hi * 8) * 2u;
#pragma unroll
      for (int d0 = 0; d0 < ND; ++d0) qr[d0] = *reinterpret_cast<const bf16x8*>(Qw + qo + d0 * 32); }
    const int rq = a.rg * 4 + (wid >> 1), cq = (wid & 1) * 32 + r32;
    unsigned koff[2], voff[2];
#pragma unroll
    for (int i = 0; i < 2; ++i) { const int q = wid * 2 + i;
        { const int row = 4 * q + (lane >> 4), c = (lane & 15) ^ (kswz(row) >> 4); koff[i] = (unsigned)(row * LDK + c * 8) * 2u; }
        { const int blk = 2 * q + (lane >> 5), kk = (blk >> 2) * 8 + ((lane >> 2) & 7), k = (kk & ~0xC) | ((kk & 4) << 1) | ((kk & 8) >> 1), c = (blk & 3) * 32 + (lane & 3) * 8; voff[i] = (unsigned)(k * LDV + c) * 2u; } }
    const int vb0 = (int)(uintptr_t)lds + 16384 + v_rd_base(lane);
#define DMA(j, b) do { const int _t0 = tile_row<MODE>(a, (j)); const char* _kb = (const char*)a.K + (size_t)_t0 * (LDK * 2); const char* _vb = (const char*)a.V + (size_t)_t0 * (LDV * 2); \
    LAS unsigned char* _d = ldsl + (b) * RING; \
    __builtin_amdgcn_global_load_lds((const unsigned*)(_kb + koff[0]), (LAS unsigned*)(_d), 16, 0, 0); __builtin_amdgcn_global_load_lds((const unsigned*)(_kb + koff[1]), (LAS unsigned*)(_d + 1024), 16, 0, 0); \
    __builtin_amdgcn_global_load_lds((const unsigned*)(_vb + voff[0]), (LAS unsigned*)(_d + 16384), 16, 0, 0); __builtin_amdgcn_global_load_lds((const unsigned*)(_vb + voff[1]), (LAS unsigned*)(_d + 16384 + 1024), 16, 0, 0); } while (0)
#define TWAIT() do { asm volatile("s_waitcnt vmcnt(4)" ::: "memory"); __syncthreads(); } while (0)
#define RESC(al) do { if (__any((al) < 1.f)) { if (hi == 0) al_l[r32] = (al); asm volatile("s_waitcnt lgkmcnt(0)" ::: "memory"); \
    _Pragma("unroll") for (int d = 0; d < 4; ++d) _Pragma("unroll") for (int r = 0; r < 16; ++r) o[d][r] *= al_l[crow(r, hi)]; } } while (0)
#define AMOD(P0, P1, j) do { if (MODE == 1 && (j) >= 4) na_mod2(P0, P1, tabl + (a.kstart + (j) - 4 - rq + 7) * 31, okm); } while (0)
    const int krs_ = min(max(rq - 4, 0), 56);
    unsigned okm = 0; { const int cs = min(max(cq - 8, 0), 48);
#pragma unroll
      for (int r = 0; r < 16; ++r) { const int kc = crow(r, hi); okm |= ((unsigned)(kc - cs) < 16u ? 1u : 0u) << r; okm |= ((unsigned)(kc + 32 - cs) < 16u ? 1u : 0u) << (16 + r); } }
    const float* tabl = tab + 48 + 15 - cq + 4 * hi;
#define TV(j) ((MODE == 0) || (j) < 4 || ((unsigned)(a.kstart + (j) - 4 - krs_) < 8u))
#define PFILL(P0, P1) do { _Pragma("unroll") for (int _r = 0; _r < 16; ++_r) { P0[_r] = -1e30f; P1[_r] = -1e30f; } } while (0)
#define KB(j) (lds + ((j) & 3) * RING)
#define VB(j) (vb0 + ((j) & 3) * RING)
    f32x16 pA0, pA1, pB0, pB1; float mnA, mnB, alA, alB; bf16x8 pa0, pa1, pa2, pa3; const int NT = a.ntiles;
    bool vA = true, vB = true;
    asm volatile("s_waitcnt vmcnt(0)" ::: "memory");
    DMA(0, 0); DMA(1, 1);
    TWAIT(); DMA(2, 2);
    qkt<DQK, 0>(pA0, pA1, KB(0), qr, r32, hi, nullptr); AMOD(pA0, pA1, 0); partialSM<DQK>(pA0, pA1, m_reg, mnA, alA);
#pragma unroll 1
    for (int j = 1; j + 1 < NT; j += 2) {
        TWAIT(); DMA(min(j + 2, NT - 1), (j + 2) & 3);
        vB = TV(j);
        SBAR(); if (vB) { qkt<DQK, 0>(pB0, pB1, KB(j), qr, r32, hi, nullptr); AMOD(pB0, pB1, j); } else { PFILL(pB0, pB1); }
        finishSM(pA0, pA1, alA, l_reg, pa0, pa1, pa2, pa3); SBAR();
        if (vA) pv_d0(o, VB(j - 1), pa0, pa1, pa2, pa3);
        partialSM<DQK>(pB0, pB1, m_reg, mnB, alB);
        RESC(alB);
        TWAIT(); DMA(min(j + 3, NT - 1), (j + 3) & 3);
        vA = TV(j + 1);
        SBAR(); if (vA) { qkt<DQK, 0>(pA0, pA1, KB(j + 1), qr, r32, hi, nullptr); AMOD(pA0, pA1, j + 1); } else { PFILL(pA0, pA1); }
        finishSM(pB0, pB1, alB, l_reg, pa0, pa1, pa2, pa3); SBAR();
        if (vB) pv_d0(o, VB(j), pa0, pa1, pa2, pa3);
        partialSM<DQK>(pA0, pA1, m_reg, mnA, alA);
        RESC(alA);
    }
    asm volatile("s_waitcnt vmcnt(0)" ::: "memory"); __syncthreads();
    vB = TV(NT - 1);
    SBAR(); if (vB) { qkt<DQK, 0>(pB0, pB1, KB(NT - 1), qr, r32, hi, nullptr); AMOD(pB0, pB1, NT - 1); } else { PFILL(pB0, pB1); }
    finishSM(pA0, pA1, alA, l_reg, pa0, pa1, pa2, pa3); SBAR();
    if (vA) pv_d0(o, VB(NT - 2), pa0, pa1, pa2, pa3);
    partialSM<DQK>(pB0, pB1, m_reg, mnB, alB);
    RESC(alB);
    finishSM(pB0, pB1, alB, l_reg, pa0, pa1, pa2, pa3); SBAR();
    if (vB) pv_d0(o, VB(NT - 1), pa0, pa1, pa2, pa3);
#undef TV
#undef PFILL
#undef KB
#undef VB
#undef DMA
#undef TWAIT
#undef RESC
#undef AMOD
    if (hi == 0) li_l[r32] = l_reg; asm volatile("s_waitcnt lgkmcnt(0)" ::: "memory");
    float rli[16];
#pragma unroll
    for (int r = 0; r < 16; ++r) rli[r] = __builtin_amdgcn_rcpf(li_l[crow(r, hi)]);
    int tz = threadIdx.x; asm volatile("" : "+v"(tz));
    bf16_t* Ow = a.O + (size_t)(__builtin_amdgcn_readfirstlane(tz >> 6) * 32) * LDO + (tz & 31);
    const int hz = (tz >> 5) & 1;
#pragma unroll
    for (int r = 0; r < 16; ++r) { const int orow = crow(r, hz);
#pragma unroll
        for (int d0 = 0; d0 < 4; ++d0) Ow[(size_t)orow * LDO + d0 * 32] = f2bf(o[d0][r] * rli[r]); }
    asm volatile("s_waitcnt vmcnt(0)" ::: "memory");
    __syncthreads();
}

template <int DQK, int LDQ, int LDK, int LDV, int LDO>
__device__ __forceinline__ void attn_body_simple(const AttnArgs& a, char* lds) {
    constexpr int KCH = DQK / 64, KROWB = AttC<DQK>::KROWB, SHM_K = 64 * KROWB, SHM_V = 64 * 128 * 2, ND = DQK / 16, KC8 = DQK / 8;
    int tid = threadIdx.x; asm volatile("" : "+v"(tid));
    const int wid = __builtin_amdgcn_readfirstlane(tid >> 6), lane = tid & 63, r32 = lane & 31, hi = lane >> 5;
    char* V_lds = lds; char* K_lds = lds + 2 * SHM_V;
    float* wsf = (float*)(lds + 2 * SHM_V + 2 * SHM_K) + wid * 64; float* li_l = wsf; float* al_l = wsf + 32;
    float m_reg = -1e30f, l_reg = 0; f32x16 o[4] = {}; bf16x8 qr[ND];
    { const char* Qw = (const char*)a.Q + (size_t)(wid * 32) * LDQ * 2; const unsigned qo = (unsigned)(r32 * LDQ + hi * 8) * 2u;
#pragma unroll
      for (int d0 = 0; d0 < ND; ++d0) qr[d0] = *reinterpret_cast<const bf16x8*>(Qw + qo + d0 * 32); }
    const int sr = tid >> 4, sc = (tid & 15) * 8, vst0 = v_st(sr, sc), vst1 = v_st(32 + sr, sc);
    const unsigned voff = (unsigned)(sr * LDV + sc) * 2u;
    unsigned koff[KCH]; int kdst[KCH];
#pragma unroll
    for (int i = 0; i < KCH; ++i) { const int cid = tid + 512 * i; const int kr_ = cid / KC8, kc_ = (cid % KC8) * 8; koff[i] = (unsigned)(kr_ * LDK + kc_) * 2u; kdst[i] = kr_ * KROWB + ((kc_ * 2) ^ kswz(kr_)); }
    const int vb0 = (int)(uintptr_t)V_lds + v_rd_base(lane);
    bf16x8 vs0, vs1, ks[KCH];
#define SLOAD(j) do { const int _t0 = a.kbase + 64 * (j); const char* _vb = (const char*)a.V + (size_t)_t0 * (LDV * 2); const char* _kb = (const char*)a.K + (size_t)_t0 * (LDK * 2); \
    vs0 = *reinterpret_cast<const bf16x8*>(_vb + voff); vs1 = *reinterpret_cast<const bf16x8*>(_vb + voff + 32 * LDV * 2); \
    _Pragma("unroll") for (int _k = 0; _k < KCH; ++_k) ks[_k] = *reinterpret_cast<const bf16x8*>(_kb + koff[_k]); } while (0)
#define SWRITE(b) do { *(bf16x8*)(V_lds + (b) * SHM_V + vst0) = vs0; *(bf16x8*)(V_lds + (b) * SHM_V + vst1) = vs1; \
    _Pragma("unroll") for (int _k = 0; _k < KCH; ++_k) *(bf16x8*)(K_lds + (b) * SHM_K + kdst[_k]) = ks[_k]; } while (0)
    f32x16 p0, p1; float mn, al; bf16x8 pa0, pa1, pa2, pa3; const int NT = a.ntiles;
    SLOAD(0); asm volatile("s_waitcnt vmcnt(0)" ::: "memory"); SWRITE(0); __syncthreads();
#pragma unroll 1
    for (int j = 0; j < NT; ++j) {
        const int b = j & 1;
        if (j + 1 < NT) SLOAD(j + 1);
        SBAR(); qkt<DQK>(p0, p1, K_lds + b * SHM_K, qr, r32, hi);
        partialSM<DQK>(p0, p1, m_reg, mn, al);
        if (__any(al < 1.f)) { if (hi == 0) al_l[r32] = al; asm volatile("s_waitcnt lgkmcnt(0)" ::: "memory");
#pragma unroll
            for (int d = 0; d < 4; ++d)
#pragma unroll
                for (int r = 0; r < 16; ++r) o[d][r] *= al_l[crow(r, hi)]; }
        finishSM(p0, p1, al, l_reg, pa0, pa1, pa2, pa3); SBAR();
        pv_d0(o, vb0 + b * SHM_V, pa0, pa1, pa2, pa3);
        if (j + 1 < NT) { asm volatile("s_waitcnt vmcnt(0)" ::: "memory"); SWRITE(b ^ 1); }
        __syncthreads();
    }
    if (hi == 0) li_l[r32] = l_reg; asm volatile("s_waitcnt lgkmcnt(0)" ::: "memory");
    float rli[16];
#pragma unroll
    for (int r = 0; r < 16; ++r) rli[r] = __builtin_amdgcn_rcpf(li_l[crow(r, hi)]);
    int tz = threadIdx.x; asm volatile("" : "+v"(tz));
    bf16_t* Ow = a.O + (size_t)(__builtin_amdgcn_readfirstlane(tz >> 6) * 32) * LDO + (tz & 31);
    const int hz = (tz >> 5) & 1;
#pragma unroll
    for (int r = 0; r < 16; ++r) { const int orow = crow(r, hz);
#pragma unroll
        for (int d0 = 0; d0 < 4; ++d0) Ow[(size_t)orow * LDO + d0 * 32] = f2bf(o[d0][r] * rli[r]); }
    __syncthreads();
#undef SLOAD
#undef SWRITE
}

template <int DQK, int MODE, int LDQ, int LDK, int LDV, int LDO, int ABL = 0>
__device__ __forceinline__ void attn_body_stag(const AttnArgs& a, char* lds, const float* tab) {
    constexpr int KCH = DQK / 64, KROWB = AttC<DQK>::KROWB, SHM_K = 64 * KROWB, SHM_V = 64 * 128 * 2, ND = DQK / 16, KC8 = DQK / 8;
    int tid = threadIdx.x; asm volatile("" : "+v"(tid));
    const int wid = __builtin_amdgcn_readfirstlane(tid >> 6), lane = tid & 63, r32 = lane & 31, hi = lane >> 5;
    char* V_lds = lds; char* K_lds = lds + 2 * SHM_V;
    float* wsf = (float*)(lds + 2 * SHM_V + 2 * SHM_K) + wid * 64; float* li_l = wsf; float* al_l = wsf + 32;
    float m_reg = -1e30f, l_reg = 0; f32x16 o[4] = {}; bf16x8 qr[ND];
    { const char* Qw = (const char*)a.Q + (size_t)(wid * 32) * LDQ * 2; const unsigned qo = (unsigned)(r32 * LDQ + hi * 8) * 2u;
#pragma unroll
      for (int d0 = 0; d0 < ND; ++d0) qr[d0] = *reinterpret_cast<const bf16x8*>(Qw + qo + d0 * 32); }
    const int sr = tid >> 4, sc = (tid & 15) * 8, vst0 = v_st(sr, sc), vst1 = v_st(32 + sr, sc);
    const unsigned voff = (unsigned)(sr * LDV + sc) * 2u;
    unsigned koff[KCH]; int kdst[KCH];
#pragma unroll
    for (int i = 0; i < KCH; ++i) { const int cid = tid + 512 * i; const int kr_ = cid / KC8, kc_ = (cid % KC8) * 8; koff[i] = (unsigned)(kr_ * LDK + kc_) * 2u; kdst[i] = kr_ * KROWB + ((kc_ * 2) ^ kswz(kr_)); }
    const int vb0 = (int)(uintptr_t)V_lds + v_rd_base(lane);
    const int rq = a.rg * 4 + (wid >> 1), cq = (wid & 1) * 32 + r32; const int krs = min(max(rq - 4, 0), 56);
    bf16x8 vs0, vs1, ks[KCH];
#define SLOADK(j) do { const char* _kb = (const char*)a.K + (size_t)tile_row<MODE>(a, (j)) * (LDK * 2); \
    _Pragma("unroll") for (int _k = 0; _k < KCH; ++_k) ks[_k] = *reinterpret_cast<const bf16x8*>(_kb + koff[_k]); } while (0)
#define SLOADV(j) do { const char* _vb = (const char*)a.V + (size_t)tile_row<MODE>(a, (j)) * (LDV * 2); \
    vs0 = *reinterpret_cast<const bf16x8*>(_vb + voff); vs1 = *reinterpret_cast<const bf16x8*>(_vb + voff + 32 * LDV * 2); } while (0)
#define SWRITEK(b) do { _Pragma("unroll") for (int _k = 0; _k < KCH; ++_k) *(bf16x8*)(K_lds + (b) * SHM_K + kdst[_k]) = ks[_k]; } while (0)
#define SWRITEV(b) do { *(bf16x8*)(V_lds + (b) * SHM_V + vst0) = vs0; *(bf16x8*)(V_lds + (b) * SHM_V + vst1) = vs1; } while (0)
#define LBAR() do { asm volatile("s_waitcnt lgkmcnt(0)" ::: "memory"); __builtin_amdgcn_s_barrier(); asm volatile("" ::: "memory"); } while (0)
    f32x16 p0 = {}, p1 = {}; float mn, al = 1.f; bf16x8 pa0, pa1, pa2, pa3; const int NT = a.ntiles;
    SLOADK(0); SLOADV(0); asm volatile("s_waitcnt vmcnt(0)" ::: "memory"); SWRITEK(0); SWRITEV(0);
    SLOADK(1); SLOADV(1);
    LBAR();
    if (wid >= 4) LBAR();
#pragma unroll 1
    for (int j = 0; j < NT; ++j) {
        const int b = j & 1;
        const bool tv = (MODE == 0) || j < 4 || ((unsigned)(a.kstart + j - 4 - krs) < 8u);
        if (!(ABL & 8)) { if (j + 1 < NT) { SWRITEK(b ^ 1); if (j + 2 < NT) SLOADK(j + 2); } }
        SBAR();
        if (tv) { if (!(ABL & 1)) qkt_p<DQK>(p0, p1, K_lds + b * SHM_K, qr, r32, hi); else { asm volatile("" : "+v"(p0), "+v"(p1)); }
            if (MODE == 1) na_mod(p0, p1, j, a.kstart, rq, cq, tab, hi);
            if (!(ABL & 2)) { partialSM<DQK>(p0, p1, m_reg, mn, al); asm volatile("" : "+v"(p0), "+v"(p1), "+v"(al)); }
            else { al = 1.f; asm volatile("" : "+v"(p0), "+v"(p1)); } }
        SBAR();
        LBAR();
        if (!(ABL & 8)) { if (j + 1 < NT) { SWRITEV(b ^ 1); if (j + 2 < NT) SLOADV(j + 2); } }
        if (tv) {
        if (__any(al < 1.f)) { if (hi == 0) al_l[r32] = al; asm volatile("s_waitcnt lgkmcnt(0)" ::: "memory");
#pragma unroll
            for (int d = 0; d < 4; ++d)
#pragma unroll
                for (int r = 0; r < 16; ++r) o[d][r] *= al_l[crow(r, hi)]; }
        if (!(ABL & 2)) finishSM(p0, p1, al, l_reg, pa0, pa1, pa2, pa3); else { pa0 = *(bf16x8*)&p0; pa1 = *((bf16x8*)&p0 + 1); pa2 = *(bf16x8*)&p1; pa3 = *((bf16x8*)&p1 + 1); l_reg += 1.f; } SBAR();
        if (!(ABL & 4)) pv_il(o, vb0 + b * SHM_V, pa0, pa1, pa2, pa3); else { asm volatile("" :: "v"(pa0), "v"(pa1), "v"(pa2), "v"(pa3)); }
        }
        LBAR();
    }
    if (wid < 4) LBAR();
    if (hi == 0) li_l[r32] = l_reg; asm volatile("s_waitcnt lgkmcnt(0)" ::: "memory");
    float rli[16];
#pragma unroll
    for (int r = 0; r < 16; ++r) rli[r] = __builtin_amdgcn_rcpf(li_l[crow(r, hi)]);
    int tz = threadIdx.x; asm volatile("" : "+v"(tz));
    bf16_t* Ow = a.O + (size_t)(__builtin_amdgcn_readfirstlane(tz >> 6) * 32) * LDO + (tz & 31);
    const int hz = (tz >> 5) & 1;
#pragma unroll
    for (int r = 0; r < 16; ++r) { const int orow = crow(r, hz);
#pragma unroll
        for (int d0 = 0; d0 < 4; ++d0) Ow[(size_t)orow * LDO + d0 * 32] = f2bf(o[d0][r] * rli[r]); }
    __syncthreads();
#undef SLOADK
#undef SLOADV
#undef SWRITEK
#undef SWRITEV
#undef LBAR
}

struct Ctx { Params p; unsigned char* ws; char* lds; int G, bid; __device__ __forceinline__ LAS unsigned char* lds_las() const { return (LAS unsigned char*)lds; } };
#define PHASE_LANES() int tid = threadIdx.x; asm volatile("" : "+v"(tid)); const int lane = tid & 63; const int wid = __builtin_amdgcn_readfirstlane(tid >> 6); (void)lane; (void)wid; \
    int Pbid = X.bid, PG = X.G; asm volatile("" : "+s"(Pbid), "+s"(PG)); (void)Pbid; (void)PG;

__device__ __forceinline__ void phase_mod(const Ctx& X) {
    PHASE_LANES();
    float* sv = (float*)X.lds; float* red = (float*)(X.lds + 40960);
    for (int i = tid; i < 5 * 2048; i += NTHR) { const int r = i >> 11, k = i & 2047; const float c = r < 4 ? X.p.c[r * 2048 + k] : X.p.c_ctx[k]; sv[i] = silu_f(c); }
    __syncthreads();
    float* MOD = (float*)(X.ws + WS_MOD);
    for (int u = Pbid; u < DEPTH * 48; u += PG) {
        const int l = u / 48, cb = u % 48; const int cq = tid & 63, kg = tid >> 6;
        const float* W = X.p.w_mod + (size_t)l * 2048 * 12288 + cb * 256 + cq * 4;
        float acc[5][4];
#pragma unroll
        for (int r = 0; r < 5; ++r)
#pragma unroll
            for (int j = 0; j < 4; ++j) acc[r][j] = 0.f;
#pragma unroll 4
        for (int k = kg; k < 2048; k += 8) { const f32x4 w = *(const f32x4*)(W + (size_t)k * 12288);
#pragma unroll
            for (int r = 0; r < 5; ++r) { const float s = sv[r * 2048 + k];
#pragma unroll
                for (int j = 0; j < 4; ++j) acc[r][j] = fmaf(s, w[j], acc[r][j]); } }
#pragma unroll
        for (int r = 0; r < 5; ++r)
#pragma unroll
            for (int j = 0; j < 4; ++j) red[(kg * 5 + r) * 256 + cq * 4 + j] = acc[r][j];
        __syncthreads();
        for (int i = tid; i < 5 * 256; i += NTHR) { const int r = i >> 8, c = i & 255; float s = X.p.b_mod[l * 12288 + cb * 256 + c];
#pragma unroll
            for (int g = 0; g < 8; ++g) s += red[(g * 5 + r) * 256 + c];
            MOD[(size_t)(l * 5 + r) * 12288 + cb * 256 + c] = s; }
        __syncthreads();
    }
}
__device__ __forceinline__ void phase_rope(const Ctx& X) {
    PHASE_LANES();
    float* R = (float*)(X.ws + WS_ROPE);
    for (int i = Pbid * NTHR + tid; i < 4096 * 32; i += PG * NTHR) {
        const int pos = i >> 5, j = i & 31; const int fi = j & 15;
        const float invf = expf(-(float)fi * (1.f / 16.f) * 9.210340371976184f);
        const float ang = (float)(j < 16 ? (pos >> 6) : (pos & 63)) * invf;
        R[i] = __cosf(ang); R[4096 * 32 + i] = __sinf(ang);
    }
    float* SP = (float*)(X.ws + WS_SP8);
    for (int i = Pbid * NTHR + tid; i < DEPTH * 2 * 1024; i += PG * NTHR) {
        const float z = -X.p.lru_lam[i]; SP[i] = 8.f * (fmaxf(z, 0.f) + log1pf(expf(-fabsf(z))));
    }
}

template <int MAP> __device__ __forceinline__ int colmap(int n) {
    if (MAP == 0) return n;
    if (MAP == 1) {
        if (n < C_KR) return n;
        if (n < C_SG) { const int p = n - C_KR; if (p >= 64) return -1; return C_KR + ((p & 1) ? 32 + (p >> 1) : (p >> 1)); }
        return n - 192;
    }
    if (MAP == 3) { const int pn = n >> 8, w = n & 255; return w < 128 ? pn * 128 + w : DFF + pn * 128 + (w - 128); }
    { const int h = n / 192, j = n % 192; if (j < 128) return n; const int p = j - 128; return h * 192 + 128 + ((p & 1) ? 32 + (p >> 1) : (p >> 1)); }
}
template <int MAP, bool SWP = false>
__device__ __forceinline__ void prep_transpose(const Ctx& X, const float* src, int ldsrc, bf16_t* dst, int K, int Np, const float* kscale, const float* shv = nullptr, float* swp = nullptr) {
    PHASE_LANES();
    float* tile = (float*)X.lds;
    f32x4 shr[5][4]; int kt_c = -1;
    const int nkt = K / 128, nnt = Np / 64, nu = nkt * nnt;
    const int q4 = (tid & 15) * 4, kr = tid >> 4;
    f32x4 v[4], w[4];
#define PT_LOAD(u_, dstv) do { const int _k0 = ((u_) % nkt) * 128, _n0 = ((u_) / nkt) * 64; \
        const int s0 = colmap<MAP>(_n0 + q4), s1 = colmap<MAP>(_n0 + q4 + 1), s2 = colmap<MAP>(_n0 + q4 + 2), s3 = colmap<MAP>(_n0 + q4 + 3); \
        const bool vec = (s0 >= 0) && (s1 == s0 + 1) && (s2 == s0 + 2) && (s3 == s0 + 3) && ((s0 & 3) == 0); \
        if (vec) { _Pragma("unroll") for (int i = 0; i < 4; ++i) dstv[i] = *(const f32x4*)(src + (size_t)(_k0 + kr + 32 * i) * ldsrc + s0); } \
        else { _Pragma("unroll") for (int i = 0; i < 4; ++i) { const float* rp = src + (size_t)(_k0 + kr + 32 * i) * ldsrc; \
            dstv[i][0] = s0 >= 0 ? rp[s0] : 0.f; dstv[i][1] = s1 >= 0 ? rp[s1] : 0.f; dstv[i][2] = s2 >= 0 ? rp[s2] : 0.f; dstv[i][3] = s3 >= 0 ? rp[s3] : 0.f; } } } while (0)
    int u = Pbid; asm volatile("" : "+s"(u));
    if (u < nu) PT_LOAD(u, v);
    for (; u < nu; u += PG) {
        const int k0 = (u % nkt) * 128, n0 = (u / nkt) * 64;
        const bool more = u + PG < nu;
        if (more) PT_LOAD(u + PG, w);
        if (SWP) { if ((k0 >> 7) != kt_c) { kt_c = k0 >> 7;
#pragma unroll
            for (int mr = 0; mr < 5; ++mr)
#pragma unroll
                for (int j4 = 0; j4 < 4; ++j4) shr[mr][j4] = *(const f32x4*)(shv + (size_t)mr * 12288 + k0 + (tid & 7) * 16 + 4 * j4); } }
#pragma unroll
        for (int i = 0; i < 4; ++i) { const int kk = kr + 32 * i; const float sc = kscale ? kscale[k0 + kk] : 1.f;
            tile[kk * 65 + q4 + 0] = v[i][0] * sc; tile[kk * 65 + q4 + 1] = v[i][1] * sc; tile[kk * 65 + q4 + 2] = v[i][2] * sc; tile[kk * 65 + q4 + 3] = v[i][3] * sc; }
        __syncthreads();
        const int nn = tid >> 3, kc = (tid & 7) * 16;
        u32x4 w0, w1;
        float t[16];
#pragma unroll
        for (int j = 0; j < 16; ++j) t[j] = tile[(kc + j) * 65 + nn];
        w0.x = cvt_pk_bf16(t[0], t[1]); w0.y = cvt_pk_bf16(t[2], t[3]); w0.z = cvt_pk_bf16(t[4], t[5]); w0.w = cvt_pk_bf16(t[6], t[7]);
        w1.x = cvt_pk_bf16(t[8], t[9]); w1.y = cvt_pk_bf16(t[10], t[11]); w1.z = cvt_pk_bf16(t[12], t[13]); w1.w = cvt_pk_bf16(t[14], t[15]);
        if (SWP) {
#pragma unroll
            for (int mr = 0; mr < 5; ++mr) { float pp = 0.f;
#pragma unroll
                for (int j4 = 0; j4 < 4; ++j4) { const f32x4 sv = shr[mr][j4]; pp += t[4 * j4] * sv[0] + t[4 * j4 + 1] * sv[1] + t[4 * j4 + 2] * sv[2] + t[4 * j4 + 3] * sv[3]; }
                pp += __int_as_float(__builtin_amdgcn_mov_dpp(__float_as_int(pp), 0xB1, 0xf, 0xf, false));
                pp += __int_as_float(__builtin_amdgcn_mov_dpp(__float_as_int(pp), 0x4E, 0xf, 0xf, false));
                pp += __int_as_float(__builtin_amdgcn_mov_dpp(__float_as_int(pp), 0x141, 0xf, 0xf, false));
                if ((tid & 7) == 0) swp[((size_t)(k0 >> 7) * 5 + mr) * 12288 + n0 + nn] = pp; }
        }
        bf16_t* dp = dst + (size_t)(n0 + nn) * K + k0 + kc;
        *(u32x4*)dp = w0; *(u32x4*)(dp + 8) = w1;
        __syncthreads();
        if (more) {
#pragma unroll
            for (int i = 0; i < 4; ++i) v[i] = w[i]; }
    }
#undef PT_LOAD
}
__device__ __forceinline__ void prep_gates(const Ctx& X, int l, size_t wo) {
    PHASE_LANES();
    bf16_t* WG = (bf16_t*)(X.ws + WS_WGATE + wo);
    const int S = PG * NTHR;
    for (int i0 = Pbid * NTHR + tid; i0 < 4096 * 256 / 2; i0 += 4 * S) {
        float v0[4], v1[4];
#pragma unroll
        for (int q = 0; q < 4; ++q) { const int i = i0 + q * S; v0[q] = 0.f; v1[q] = 0.f;
            if (i < 4096 * 256 / 2) { const int e = i * 2; const int n = e >> 8, kk = e & 255;
                const int d = n >> 11, k = (n >> 8) & 7, g = (n >> 7) & 1, dout = n & 127;
                if ((kk >> 7) == (k & 1)) { const float* W = (g ? X.p.lru_w_x : X.p.lru_w_a) + ((size_t)((l * 2 + d) * 8 + k) * 128) * 128;
                    v0[q] = W[(size_t)(kk & 127) * 128 + dout]; v1[q] = W[(size_t)((kk + 1) & 127) * 128 + dout]; } } }
        asm volatile("" : "+v"(v0[0]), "+v"(v0[1]), "+v"(v0[2]), "+v"(v0[3]), "+v"(v1[0]), "+v"(v1[1]), "+v"(v1[2]), "+v"(v1[3]));
#pragma unroll
        for (int q = 0; q < 4; ++q) { const int i = i0 + q * S; if (i < 4096 * 256 / 2) *(unsigned*)(WG + i * 2) = cvt_pk_bf16(v0[q], v1[q]); }
    }
}
__device__ __forceinline__ void phase_prep(const Ctx& X, int l, int parts, size_t wo) {
    const Params& p = X.p;
    if (parts & 1) {
        prep_transpose<1, true>(X, p.w_in + (size_t)l * 2048 * DIN_SRC, DIN_SRC, (bf16_t*)(X.ws + WS_WIN + wo), 2048, DIN, nullptr, (const float*)(X.ws + WS_MOD) + (size_t)l * 5 * 12288, (float*)(X.ws + WS_SWP) + (size_t)((l & 1) * 2 + 0) * 16 * 5 * 12288);
        prep_transpose<3, true>(X, p.ffn_w_up + (size_t)l * 2048 * DFF2, DFF2, (bf16_t*)(X.ws + WS_WUP + wo), 2048, DFF2, nullptr, (const float*)(X.ws + WS_MOD) + (size_t)l * 5 * 12288 + 3 * 2048, (float*)(X.ws + WS_SWP) + (size_t)((l & 1) * 2 + 1) * 16 * 5 * 12288);
    }
    if (parts & 2) {
        prep_transpose<2>(X, p.mla_w_q_up + (size_t)l * 512 * 1536, 1536, (bf16_t*)(X.ws + WS_WQ + wo), 512, 1536, p.mla_q_norm + l * 512);
        prep_transpose<0>(X, p.mla_w_kv_up + (size_t)l * 256 * 2048, 2048, (bf16_t*)(X.ws + WS_WKV + wo), 256, 2048, p.mla_kv_norm + l * 256);
        prep_transpose<0>(X, p.w_branch + (size_t)l * 3 * 1024 * 2048, 2048, (bf16_t*)(X.ws + WS_WBR + wo), 3072, 2048, nullptr);
        prep_gates(X, l, wo);
    }
    if (parts & 4) {
        prep_transpose<0>(X, p.w_out + (size_t)l * 2048 * 2048, 2048, (bf16_t*)(X.ws + WS_WOUT + wo), 2048, 2048, nullptr);
        prep_transpose<0>(X, p.ffn_w_down + (size_t)l * DFF * 2048, 2048, (bf16_t*)(X.ws + WS_WDOWN + wo), DFF, 2048, nullptr);
    }
}

__device__ __forceinline__ void phase_norm(const Ctx& X, int l, const float* gain, int sh_chunk, int upd, int fold_goff, int src_mode, int nidx, int ctx_only, int w0 = 0) {
    PHASE_LANES();
    const float* MOD = (const float*)(X.ws + WS_MOD); bf16_t* H = (bf16_t*)(X.ws + WS_H); unsigned short* XS = (unsigned short*)(X.ws + WS_XS);
    const unsigned short* PART = (const unsigned short*)(X.ws + WS_PART); const unsigned short* DL = (const unsigned short*)(X.ws + WS_DELTA);
    const int nrows = ctx_only ? NB * CTXL : TT;
    if (Pbid < w0) return;
    for (int ri = (Pbid - w0) * 8 + wid; ri < nrows; ri += (PG - w0) * 8) {
        const int r = ctx_only ? (ri >> 8) * SEGT + (ri & 255) : ri;
        const int b = r / SEGT, rem = r % SEGT; const bool isctx = rem < CTXL; const int mr = isctx ? 4 : b;
        unsigned short* xr = XS + (size_t)r * 2048;
        f32x4 v[8]; float ss = 0.f;
        if (src_mode == 1) { const float* xs = isctx ? X.p.ctx + ((size_t)b * 256 + rem) * 2048 : X.p.x + ((size_t)b * 4096 + (rem - 256)) * 2048;
#pragma unroll
            for (int k = 0; k < 8; ++k) v[k] = *(const f32x4*)(xs + k * 256 + lane * 4);
        } else {
#pragma unroll
            for (int k = 0; k < 8; ++k) { const u32x2 w = *(const u32x2*)(xr + k * 256 + lane * 4); v[k] = (f32x4){h2lo(w.x), h2hi(w.x), h2lo(w.y), h2hi(w.y)}; }
        }
        if (upd) {
            if (isctx && fold_goff >= 0) {
                const float* gp = MOD + fold_goff + 4 * 12288;
                const unsigned short* pt = PART + ((size_t)(b * 8) * KSPLIT) * 65536 + (size_t)rem * 256 + lane * 4;
                f32x4 sum[8];
#pragma unroll
                for (int k = 0; k < 8; ++k) sum[k] = (f32x4){0.f, 0.f, 0.f, 0.f};
#pragma unroll 1
                for (int sl = 0; sl < KSPLIT; sl += 4) {
                    u32x2 wq[4][8];
#pragma unroll
                    for (int q = 0; q < 4; ++q)
#pragma unroll
                        for (int k = 0; k < 8; ++k) wq[q][k] = *(const u32x2*)(pt + (size_t)k * KSPLIT * 65536 + (size_t)q * 65536);
#pragma unroll
                    for (int q = 0; q < 4; ++q)
#pragma unroll
                        for (int k = 0; k < 8; ++k) { sum[k][0] += h2lo(wq[q][k].x); sum[k][1] += h2hi(wq[q][k].x); sum[k][2] += h2lo(wq[q][k].y); sum[k][3] += h2hi(wq[q][k].y); }
                    pt += 4 * 65536;
                }
#pragma unroll
                for (int k = 0; k < 8; ++k) v[k] += *(const f32x4*)(gp + k * 256 + lane * 4) * sum[k];
            } else if (!isctx) {
#pragma unroll
                for (int k = 0; k < 8; ++k) { const u32x2 dw = *(const u32x2*)(DL + (size_t)r * 2048 + k * 256 + lane * 4);
                    v[k][0] += h2lo(dw.x); v[k][1] += h2hi(dw.x); v[k][2] += h2lo(dw.y); v[k][3] += h2hi(dw.y); }
            }
        }
        if (upd || src_mode == 1) {
#pragma unroll
            for (int k = 0; k < 8; ++k) { u32x2 w; w.x = pack_h2(v[k][0], v[k][1]); w.y = pack_h2(v[k][2], v[k][3]); *(u32x2*)(xr + k * 256 + lane * 4) = w; }
        }
#pragma unroll
        for (int k = 0; k < 8; ++k) ss += v[k][0] * v[k][0] + v[k][1] * v[k][1] + v[k][2] * v[k][2] + v[k][3] * v[k][3];
        ss = wave_sum(ss);
        if (lane == 0) ((unsigned long long*)(X.ws + WS_SSQ))[(size_t)nidx * TT + r] = __float2ull_rn(ss * 16777216.f);
        const float* sh = MOD + (size_t)(l * 5 + mr) * 12288 + sh_chunk * 2048; const float* scp = sh + 2048;
        f32x4 gq[8], sq[8];
#pragma unroll
        for (int k = 0; k < 8; ++k) { gq[k] = *(const f32x4*)(gain + k * 256 + lane * 4); sq[k] = *(const f32x4*)(scp + k * 256 + lane * 4); }
        asm volatile("" ::: "memory");
#pragma unroll
        for (int k = 0; k < 8; ++k) { const int c = k * 256 + lane * 4;
            const f32x4 g = gq[k], s2 = sq[k];
            f32x4 y;
#pragma unroll
            for (int j = 0; j < 4; ++j) y[j] = v[k][j] * (g[j] * (1.f + s2[j]));
            u32x2 w; w.x = cvt_pk_bf16(y[0], y[1]); w.y = cvt_pk_bf16(y[2], y[3]);
            *(u32x2*)(H + (size_t)r * 2048 + c) = w; }
    }
}
__device__ __forceinline__ void phase_swreduce(const Ctx& X, int kind, int par) {
    PHASE_LANES();
    const float* P = (const float*)(X.ws + WS_SWP) + (size_t)(par * 2 + kind) * 16 * 5 * 12288; float* SW = (float*)(X.ws + WS_SW) + (size_t)kind * 5 * 12288;
    for (int i = Pbid * NTHR + tid; i < 5 * 12288; i += PG * NTHR) { float pv[16];
#pragma unroll
        for (int kt = 0; kt < 16; ++kt) pv[kt] = P[(size_t)kt * 5 * 12288 + i];
        asm volatile("" : "+v"(pv[0]), "+v"(pv[1]), "+v"(pv[2]), "+v"(pv[3]), "+v"(pv[4]), "+v"(pv[5]), "+v"(pv[6]), "+v"(pv[7]), "+v"(pv[8]), "+v"(pv[9]), "+v"(pv[10]), "+v"(pv[11]), "+v"(pv[12]), "+v"(pv[13]), "+v"(pv[14]), "+v"(pv[15]));
        float a = 0.f;
#pragma unroll
        for (int kt = 0; kt < 16; ++kt) a += pv[kt];
        SW[i] = a; }
}
__device__ __forceinline__ void phase_xinit(const Ctx& X) {
    PHASE_LANES();
    float* XS = (float*)(X.ws + WS_XS);
    for (int i = Pbid * NTHR + tid; i < TT * 512; i += PG * NTHR) {
        const int r = i >> 9, c = (i & 511) * 4; const int b = r / SEGT, rem = r % SEGT;
        const float* src = rem < CTXL ? X.p.ctx + ((size_t)b * 256 + rem) * 2048 : X.p.x + ((size_t)b * 4096 + (rem - 256)) * 2048;
        *(f32x4*)(XS + (size_t)r * 2048 + c) = *(const f32x4*)(src + c);
    }
}
__device__ __forceinline__ void phase_final(const Ctx& X) {
    PHASE_LANES();
    const unsigned short* XS = (const unsigned short*)(X.ws + WS_XS);
    f32x4 gfin[8];
#pragma unroll
    for (int k = 0; k < 8; ++k) gfin[k] = *(const f32x4*)(X.p.norm_final + k * 256 + lane * 4);
    for (int i0 = (Pbid * 8 + wid) * 2; i0 < NB * SEQ; i0 += PG * 8 * 2) {
        u32x2 xw[2][8];
#pragma unroll
        for (int q = 0; q < 2; ++q) { const int i = i0 + q; const int b = i / SEQ, s = i % SEQ; const size_t r = (size_t)b * SEGT + 256 + s;
#pragma unroll
            for (int k = 0; k < 8; ++k) xw[q][k] = *(const u32x2*)(XS + r * 2048 + k * 256 + lane * 4); }
#pragma unroll
        for (int q = 0; q < 2; ++q) { const int i = i0 + q;
            f32x4 v[8]; float ss = 0.f;
#pragma unroll
            for (int k = 0; k < 8; ++k) { v[k][0] = h2lo(xw[q][k].x); v[k][1] = h2hi(xw[q][k].x); v[k][2] = h2lo(xw[q][k].y); v[k][3] = h2hi(xw[q][k].y);
                ss += v[k][0] * v[k][0] + v[k][1] * v[k][1] + v[k][2] * v[k][2] + v[k][3] * v[k][3]; }
            ss = wave_sum(ss); const float rs = rsqrtf(ss * (1.f / 2048.f) + EPS);
#pragma unroll
            for (int k = 0; k < 8; ++k) { const int c = k * 256 + lane * 4; const f32x4 g = gfin[k];
                f32x4 y;
#pragma unroll
                for (int j = 0; j < 4; ++j) y[j] = v[k][j] * rs * g[j];
                *(f32x4*)(X.p.out + (size_t)i * 2048 + c) = y; }
        }
    }
}

__device__ __forceinline__ void phase_lruconv(const Ctx& X, int l) {
    PHASE_LANES();
    { const float* HLX = (const float*)(X.ws + WS_HLX); bf16_t* U = (bf16_t*)(X.ws + WS_U);
      const float* cw = X.p.lru_conv_w + (size_t)l * 4 * 1024; const float* cb = X.p.lru_conv_b + (size_t)l * 1024;
      for (int i = Pbid * NTHR + tid; i < NB * 15 * 3 * 256; i += PG * NTHR) {
          const int c = (i & 255) * 4; int q = i >> 8; const int which = q % 3; q /= 3; const int bi = q % 15, b = q / 15;
          const int pmU = b * PAN + 1 + bi, pmL = pmU + 1;
          const float* hU = HLX + (size_t)pmU * 6 * 1024 + c; const float* hL = HLX + (size_t)pmL * 6 * 1024 + c;
          const float *x0, *x1, *x2, *x3; size_t orow;
          if (which == 0) { x0 = hU + 3 * 1024; x1 = hU + 4 * 1024; x2 = hU + 5 * 1024; x3 = hL; orow = (size_t)pmU * 256 + 255; }
          else if (which == 1) { x0 = hU + 4 * 1024; x1 = hU + 5 * 1024; x2 = hL; x3 = hL + 1024; orow = (size_t)pmL * 256; }
          else { x0 = hU + 5 * 1024; x1 = hL; x2 = hL + 1024; x3 = hL + 2048; orow = (size_t)pmL * 256 + 1; }
          const f32x4 lb = *(const f32x4*)(cb + c), l0 = *(const f32x4*)(cw + c), l1 = *(const f32x4*)(cw + 1024 + c), l2 = *(const f32x4*)(cw + 2048 + c), l3 = *(const f32x4*)(cw + 3072 + c);
          const f32x4 y0 = *(const f32x4*)x0, y1 = *(const f32x4*)x1, y2 = *(const f32x4*)x2, y3 = *(const f32x4*)x3;
          asm volatile("" ::: "memory");
          const f32x4 uu = lb + l0 * y0 + l1 * y1 + l2 * y2 + l3 * y3;
          u32x2 w; w.x = cvt_pk_bf16(uu[0], uu[1]); w.y = cvt_pk_bf16(uu[2], uu[3]);
          *(u32x2*)(U + orow * 1024 + c) = w;
      } }
    const bf16_t* CQ = (const bf16_t*)(X.ws + WS_CQ); const bf16_t* CKV = (const bf16_t*)(X.ws + WS_CKV);
    float* RSQ = (float*)(X.ws + WS_RSQ); float* RSKV = (float*)(X.ws + WS_RSKV);
    for (int r4 = (Pbid * 8 + wid) * 4; r4 < TT; r4 += PG * 8 * 4) {
        u32x4 a[4]; u32x2 k[4];
#pragma unroll
        for (int q = 0; q < 4; ++q) { a[q] = *(const u32x4*)(CQ + (size_t)(r4 + q) * 512 + lane * 8); k[q] = *(const u32x2*)(CKV + (size_t)(r4 + q) * 256 + lane * 4); }
#pragma unroll
        for (int q = 0; q < 4; ++q) {
            float s = bflo(a[q].x) * bflo(a[q].x) + bfhi(a[q].x) * bfhi(a[q].x) + bflo(a[q].y) * bflo(a[q].y) + bfhi(a[q].y) * bfhi(a[q].y) + bflo(a[q].z) * bflo(a[q].z) + bfhi(a[q].z) * bfhi(a[q].z) + bflo(a[q].w) * bflo(a[q].w) + bfhi(a[q].w) * bfhi(a[q].w);
            float s2 = bflo(k[q].x) * bflo(k[q].x) + bfhi(k[q].x) * bfhi(k[q].x) + bflo(k[q].y) * bflo(k[q].y) + bfhi(k[q].y) * bfhi(k[q].y);
            s = wave_sum(s); s2 = wave_sum(s2);
            if (lane == 0) { RSQ[r4 + q] = rsqrtf(s * (1.f / 512.f) + EPS); RSKV[r4 + q] = rsqrtf(s2 * (1.f / 256.f) + EPS); }
        }
    }
}

__device__ __forceinline__ void phase_na(const Ctx& X, int l, bool with_ctx) {
    PHASE_LANES();
    const bf16_t* QKV = (const bf16_t*)(X.ws + WS_QKV); bf16_t* BR = (bf16_t*)(X.ws + WS_BR);
    float* tab = (float*)(X.lds + LDS_EXCH + 2048)    ;
    const int nlat = NB * 16 * 8, nctx = with_ctx ? NB * 8 : 0;
    for (int u = Pbid; u < nlat + nctx; u += PG) {
        if (u < nlat) {
            const int h = u & 7, rg = (u >> 3) & 15, b = u >> 7;
            for (int i = tid; i < NA_TABP; i += NTHR) { const int ix = i - 48; tab[i] = (unsigned)ix < 465u ? X.p.na_rpb[(size_t)(l * 8 + h) * 465 + ix] * 11.313708498984761f : 0.f; }
            AttnArgs a; const int base = b * SEGT;
            a.Q = QKV + (size_t)(base + 256 + rg * 256) * 3072 + h * 128; a.ldq = 3072;
            a.K = QKV + 1024 + h * 128; a.ldk = 3072; a.V = QKV + 2048 + h * 128; a.ldv = 3072;
            a.O = BR + (size_t)(base + 256 + rg * 256) * 3072 + h * 128; a.ldo = 3072;
            a.ntiles = 16; a.kbase = 0; a.ctxbase = base; a.latbase = base + 256; a.kstart = min(max(rg * 4 - 4, 0), 52); a.rg = rg;
            attn_body_dma<1, 3072, 3072, 3072, 3072>(a, X.lds, tab);
        } else {
            const int v = u - nlat; const int h = v & 7, b = v >> 3; const int base = b * SEGT;
            AttnArgs a;
            a.Q = QKV + (size_t)base * 3072 + h * 128; a.ldq = 3072;
            a.K = QKV + 1024 + h * 128; a.ldk = 3072; a.V = QKV + 2048 + h * 128; a.ldv = 3072;
            a.O = BR + (size_t)base * 3072 + h * 128; a.ldo = 3072;
            a.ntiles = 4; a.kbase = base; a.ctxbase = 0; a.latbase = 0; a.kstart = 0; a.rg = 0;
            attn_body_dma<0, 3072, 3072, 3072, 3072>(a, X.lds, tab);
        }
    }
}
template <int ABL> __device__ __forceinline__ void phase_mla(const Ctx& X, bool with_ctx) {
    PHASE_LANES();
    const bf16_t* QM = (const bf16_t*)(X.ws + WS_QM); const bf16_t* KM = (const bf16_t*)(X.ws + WS_KM); const bf16_t* VM = (const bf16_t*)(X.ws + WS_VM);
    bf16_t* BR = (bf16_t*)(X.ws + WS_BR) + 2048;
    const int nlat = NB * 16 * 8, nctx = with_ctx ? NB * 8 : 0;
    for (int u = Pbid; u < nlat + nctx; u += PG) {
        AttnArgs a; int h, base, q0;
        if (u < nlat) { h = u & 7; const int qb = (u >> 3) & 15, b = u >> 7; base = b * SEGT; q0 = base + 256 + qb * 256; a.ntiles = 68; }
        else { const int v = u - nlat; h = v & 7; base = (v >> 3) * SEGT; q0 = base; a.ntiles = 4; }
        a.Q = QM + (size_t)q0 * 1536 + h * 192; a.ldq = 1536; a.K = KM + h * 192; a.ldk = 1536; a.V = VM + h * 128; a.ldv = 1024;
        a.O = BR + (size_t)q0 * 3072 + h * 128; a.ldo = 3072; a.kbase = base; a.ctxbase = 0; a.latbase = 0; a.kstart = 0; a.rg = 0;
        if (ABL) a.O = (bf16_t*)(X.ws + WS_QKV) + (size_t)q0 * 3072 + h * 128;
#ifdef MLA_PIPE
        attn_body<192, 0, 1, 1536, 1536, 1024, 3072, 4>(a, X.lds, nullptr);
#else
        attn_body_stag<192, 0, 1536, 1536, 1024, 3072, ABL>(a, X.lds, nullptr);
#endif
    }
}

__device__ __forceinline__ void lru_ab(unsigned w, float spl2, float& a, float& b) { a = __builtin_amdgcn_exp2f(-(float)(w & 0xffffu) * spl2); b = __uint_as_float(w & 0xffff0000u); }
__device__ __forceinline__ void phase_scan1(const Ctx& X, int l) {
    PHASE_LANES();
    const unsigned* AB = (const unsigned*)(X.ws + WS_AB); const float* SP = (const float*)(X.ws + WS_SP8) + l * 2048;
    float* P = (float*)(X.ws + WS_PS); float* S = P + (size_t)NB * 2 * 68 * 1024;
    for (int i = Pbid * NTHR + tid; i < NB * 2 * 68 * 256 * 4; i += PG * NTHR) {
        const int seg = i & 3; const int c = ((i >> 2) & 255) * 4; const int ch = (i >> 10) % 68; const int bd = (i >> 10) / 68; const int d = bd & 1, b = bd >> 1;
        const size_t t0 = (size_t)b * SEGT + ch * 64;
        const unsigned* ap = AB + ((size_t)d * TT + t0) * 1024 + c;
        const f32x4 sl = *(const f32x4*)(SP + d * 1024 + c) * (1.4426950408889634f / 65535.f);
        f32x4 pp = {1.f, 1.f, 1.f, 1.f}, ss = {0.f, 0.f, 0.f, 0.f};
#pragma unroll
        for (int s = 0; s < 16; ++s) { const int q = seg * 16 + s; const int t = d ? 63 - q : q; const u32x4 w = *(const u32x4*)(ap + (size_t)t * 1024);
#pragma unroll
            for (int j = 0; j < 4; ++j) { float a, bb; lru_ab(w[j], sl[j], a, bb); pp[j] *= a; ss[j] = a * ss[j] + bb; } }
#pragma unroll
        for (int j = 0; j < 4; ++j) {
            float pe = __int_as_float(__builtin_amdgcn_update_dpp(0, __float_as_int(pp[j]), 0xA0  , 0xf, 0xf, false));
            float se = __int_as_float(__builtin_amdgcn_update_dpp(0, __float_as_int(ss[j]), 0xA0, 0xf, 0xf, false));
            if (seg & 1) { ss[j] = pp[j] * se + ss[j]; pp[j] = pp[j] * pe; }
            pe = __int_as_float(__builtin_amdgcn_update_dpp(0, __float_as_int(pp[j]), 0x55  , 0xf, 0xf, false));
            se = __int_as_float(__builtin_amdgcn_update_dpp(0, __float_as_int(ss[j]), 0x55, 0xf, 0xf, false));
            if (seg == 3) { ss[j] = pp[j] * se + ss[j]; pp[j] = pp[j] * pe; }
        }
        if (seg == 3) { *(f32x4*)(P + ((size_t)bd * 68 + ch) * 1024 + c) = pp; *(f32x4*)(S + ((size_t)bd * 68 + ch) * 1024 + c) = ss; }
    }
}
__device__ __forceinline__ void phase_scan2(const Ctx& X, int l) {
    PHASE_LANES();
    const unsigned* AB = (const unsigned*)(X.ws + WS_AB); const float* SP = (const float*)(X.ws + WS_SP8) + l * 2048;
    const float* P = (const float*)(X.ws + WS_PS); const float* S = P + (size_t)NB * 2 * 68 * 1024;
    const bf16_t* LG = (const bf16_t*)(X.ws + WS_LG); bf16_t* BR = (bf16_t*)(X.ws + WS_BR) + 1024;
    unsigned* slab = (unsigned*)X.lds;
    const int d = tid >> 8, ct = tid & 255;
    for (int u = (Pbid + 64) % PG; u < NB * 68 * 4; u += PG) {
        const int qt = u & 3, ch = (u >> 2) % 68, b = (u >> 2) / 68; const int c = qt * 256 + ct;
        const size_t t0 = (size_t)b * SEGT + ch * 64;
        u32x4 st[16], gl[4];
#pragma unroll
        for (int i = 0; i < 16; ++i) { const int e = tid + 512 * i; const int dd = e >> 12, row = (e >> 6) & 63, c4 = (e & 63) * 4;
            st[i] = *(const u32x4*)(AB + ((size_t)dd * TT + t0 + row) * 1024 + qt * 256 + c4); }
#pragma unroll
        for (int i = 0; i < 4; ++i) { const int e = tid + 512 * i; gl[i] = *(const u32x4*)(LG + (t0 + (e >> 5)) * 1024 + qt * 256 + (e & 31) * 8); }
        float h = 0.f;
        { const float* Pd = P + ((size_t)(b * 2 + d) * 68) * 1024 + c; const float* Sd = S + ((size_t)(b * 2 + d) * 68) * 1024 + c;
          const int cnt = d == 0 ? ch : (ch < 4 ? 3 - ch : 4 + 67 - ch);
          for (int k0 = 0; k0 < cnt; k0 += 8) {
              float pv[8], sv[8];
#pragma unroll
              for (int k = 0; k < 8; ++k) { int kk = k0 + k; kk = kk < cnt ? kk : cnt - 1; const int q = d == 0 ? kk : (kk < 4 ? 3 - kk : 71 - kk);
                  pv[k] = Pd[(size_t)q * 1024]; sv[k] = Sd[(size_t)q * 1024]; }
#pragma unroll
              for (int k = 0; k < 8; ++k) { const bool on = k0 + k < cnt; h = on ? pv[k] * h + sv[k] : h; }
          } }
#pragma unroll
        for (int i = 0; i < 16; ++i) { const int e = tid + 512 * i; *(u32x4*)(slab + (e >> 6) * 256 + (e & 63) * 4) = st[i]; }
        __syncthreads();
        { const float sl = SP[d * 1024 + c] * (1.4426950408889634f / 65535.f); unsigned* col = slab + d * 64 * 256 + ct;
          unsigned wv[8], wn[8];
#pragma unroll
          for (int k = 0; k < 8; ++k) wv[k] = col[(d ? 63 - k : k) * 256];
#pragma unroll 1
          for (int s0 = 0; s0 < 64; s0 += 8) {
#pragma unroll
              for (int k = 0; k < 8; ++k) { const int sn = (s0 + 8 + k) & 63; wn[k] = col[(d ? 63 - sn : sn) * 256]; }
              asm volatile("" : "+v"(wn[0]), "+v"(wn[1]), "+v"(wn[2]), "+v"(wn[3]), "+v"(wn[4]), "+v"(wn[5]), "+v"(wn[6]), "+v"(wn[7]));
              float hv[8];
#pragma unroll
              for (int k = 0; k < 8; ++k) { float a, bb; lru_ab(wv[k], sl, a, bb); h = a * h + bb; hv[k] = h; }
#pragma unroll
              for (int k = 0; k < 8; ++k) { const int sq = s0 + k; col[(d ? 63 - sq : sq) * 256] = __float_as_uint(hv[k]); }
#pragma unroll
              for (int k = 0; k < 8; ++k) wv[k] = wn[k];
          } }
        __syncthreads();
#pragma unroll
        for (int i = 0; i < 4; ++i) { const int e = tid + 512 * i; const int row = e >> 5, c8 = (e & 31) * 8;
            const f32x4 f0 = *(const f32x4*)(slab + row * 256 + c8), f1 = *(const f32x4*)(slab + row * 256 + c8 + 4);
            const f32x4 b0 = *(const f32x4*)(slab + (64 + row) * 256 + c8), b1 = *(const f32x4*)(slab + (64 + row) * 256 + c8 + 4);
            const f32x4 y0 = f0 + b0, y1 = f1 + b1;
            const u32x4 g = gl[i];
            u32x4 o; o.x = cvt_pk_bf16(bflo(g.x) * y0[0], bfhi(g.x) * y0[1]); o.y = cvt_pk_bf16(bflo(g.y) * y0[2], bfhi(g.y) * y0[3]);
            o.z = cvt_pk_bf16(bflo(g.z) * y1[0], bfhi(g.z) * y1[1]); o.w = cvt_pk_bf16(bflo(g.w) * y1[2], bfhi(g.w) * y1[3]);
            *(u32x4*)(BR + (t0 + row) * 3072 + qt * 256 + c8) = o; }
        __syncthreads();
    }
}

__device__ __forceinline__ void phase_ffnfix(const Ctx& X, int l) {
    PHASE_LANES();
    const float* HALO = (const float*)(X.ws + WS_HALO); bf16_t* ACT = (bf16_t*)(X.ws + WS_ACT);
    const float* cw = X.p.ffn_conv_w + (size_t)l * 3 * DFF2; const float* cb = X.p.ffn_conv_b + (size_t)l * DFF2;
    for (int i = Pbid * NTHR + tid; i < NB * 15 * 2 * (DFF / 4); i += PG * NTHR) {
        const int j = (i % (DFF / 4)) * 4; int q = i / (DFF / 4); const int which = q & 1; q >>= 1; const int bi = q % 15, b = q / 15;
        const int pmU = b * PAN + 1 + bi, pmL = pmU + 1;
        const float* hU = HALO + (size_t)pmU * 4 * DFF2; const float* hL = HALO + (size_t)pmL * 4 * DFF2;
        const float *rp, *rc, *rn; size_t orow;
        if (which == 0) { rp = hU + 2 * DFF2; rc = hU + 3 * DFF2; rn = hL; orow = (size_t)pmU * 256 + 255; }
        else { rp = hU + 3 * DFF2; rc = hL; rn = hL + DFF2; orow = (size_t)pmL * 256; }
        f32x4 uv = *(const f32x4*)(cb + j), ug = *(const f32x4*)(cb + DFF + j);
        uv += *(const f32x4*)(cw + j) * *(const f32x4*)(rp + j) + *(const f32x4*)(cw + DFF2 + j) * *(const f32x4*)(rc + j) + *(const f32x4*)(cw + 2 * DFF2 + j) * *(const f32x4*)(rn + j);
        ug += *(const f32x4*)(cw + DFF + j) * *(const f32x4*)(rp + DFF + j) + *(const f32x4*)(cw + DFF2 + DFF + j) * *(const f32x4*)(rc + DFF + j) + *(const f32x4*)(cw + 2 * DFF2 + DFF + j) * *(const f32x4*)(rn + DFF + j);
        u32x2 w; w.x = cvt_pk_bf16(silu_f(ug[0]) * uv[0], silu_f(ug[1]) * uv[1]); w.y = cvt_pk_bf16(silu_f(ug[2]) * uv[2], silu_f(ug[3]) * uv[3]);
        *(u32x2*)(ACT + orow * DFF + j) = w;
    }
}

template <class Epi>
__device__ __forceinline__ void run_gemm(const Ctx& X, const bf16_t* A, int lda, const bf16_t* Bt, int ldb, int N, int K, const Epi& E, int omode = 0, int amask = 0, int ashift = 0, int astep = 0) {
    int Gq = X.G, Bq = X.bid; asm volatile("" : "+s"(Gq), "+s"(Bq));
    int Kv = K; asm volatile("" : "+s"(Kv));
    pg8::Gemm g{A, lda, Bt, ldb, TT, N, Kv, amask, ashift, astep}; pg8::Order S; S.init(N, Kv, Gq, Bq, omode, KSPLIT);
    __syncthreads();
    pg8::gemm_phase<Epi>((LAS unsigned char*)X.lds, g, S, E);
}

constexpr int PH_PER_LAYER = 12;
constexpr int N_PHASES = 1 + DEPTH * PH_PER_LAYER + 1;

__global__ void __launch_bounds__(NTHR, 2) fwd_kernel(Params p) {
    extern __shared__ __attribute__((aligned(16))) unsigned char lds_raw[];
    Ctx X; X.p = p; X.ws = p.ws; X.lds = (char*)lds_raw; X.G = gridDim.x; X.bid = blockIdx.x;
    const int lo = p.ph_lo, hi = p.ph_hi;
    volatile LAS unsigned* barw = (volatile LAS unsigned*)(lds_raw + LDS_BARW);
    if (threadIdx.x < 4) barw[threadIdx.x] = 0u;
    __syncthreads();
    XcdBarrier bar; bar.bar = (unsigned*)(p.ws + WS_BAR); bar.x = 0; bar.st = barw;
    if (hi - lo > 1) bar = xcd_barrier_post((unsigned*)(p.ws + WS_BAR), barw);
#ifndef PHMASK
#define PHMASK 0xFFFF
#endif
#define IN(k) (lo <= (k) && (k) < hi)
#define EN(i) ((PHMASK >> (i)) & 1)
#ifndef DUPMASK
#define DUPMASK 0
#endif
#ifndef DUPN
#define DUPN 1
#endif
#define REPS(i) (((DUPMASK >> (i)) & 1) ? 1 + DUPN : 1)
#ifdef EXTRA_BAR
#define SEAM(k) do { if (IN(k) && IN((k) + 1)) { xcd_barrier(bar); xcd_barrier(bar); } } while (0)
#else
#define SEAM(k) do { if (IN(k) && IN((k) + 1)) xcd_barrier(bar); } while (0)
#endif
    unsigned char* ws = p.ws;
    const float* rope = (const float*)(ws + WS_ROPE);

    if (EN(12) && IN(0)) { phase_mod(X); phase_rope(X);
        { unsigned long long* SQ = (unsigned long long*)(ws + WS_SSQ); for (int i = X.bid * NTHR + threadIdx.x; i < 8 * TT; i += X.G * NTHR) __hip_atomic_store(SQ + i, 0ull, __ATOMIC_RELAXED, __HIP_MEMORY_SCOPE_AGENT); } }
    SEAM(0);
    for (int l = 0; l < DEPTH; ++l) {
        const int pb = 1 + l * PH_PER_LAYER; const bool lastl = (l == DEPTH - 1);
        const size_t wo = (size_t)(l & 1) * WSET_BYTES; int Gv_ = X.G; asm volatile("" : "+s"(Gv_)); const bool early = (Gv_ == 256);
        const bool mg0 = (l > 0) && early && (hi - lo > 1);
        if (EN(0) && IN(pb + 0)) _Pragma("unroll 1") for (int rep = 0; rep < REPS(0); ++rep) { if (l == 0 || !early) { phase_prep(X, l, 1, wo); if (hi - lo > 1) xcd_barrier(bar); }
            const bool tp0 = (l == 0) && early && (hi - lo > 1);
            if (!mg0) phase_prep(X, l, tp0 ? 4 : 6, wo);
            phase_norm(X, l, p.norm_mix + l * 2048, 0, (l > 0 && rep == 0) ? 1 : 0, l > 0 ? (l - 1) * 5 * 12288 + 5 * 2048 : -1, l == 0 ? 1 : 0, 2 * l, l > 0 ? 1 : 0);
            if (!mg0) phase_swreduce(X, 0, l & 1); else split_arrive((unsigned*)(ws + WS_BAR), 2 * l); }
        if (!mg0) SEAM(pb + 0);
        if (EN(1) && IN(pb + 1)) _Pragma("unroll 1") for (int rep = 0; rep < REPS(1); ++rep) { EpiInProj E{ws, rope, p.lru_conv_w + (size_t)l * 4 * 1024, p.lru_conv_b + (size_t)l * 1024, X.lds, RowScale{ws + WS_SSQ + (size_t)(2 * l) * TT * 8, (const float*)(ws + WS_SW), (unsigned*)(ws + WS_BAR), mg0 ? 2 * l : -1, (unsigned)X.G}}; run_gemm(X, (const bf16_t*)(ws + WS_H), 2048, (const bf16_t*)(ws + WS_WIN + wo), 2048, DIN, 2048, E, mg0 ? 3 : 0);
            if ((mg0 || ((l == 0) && early && (hi - lo > 1))) && X.bid >= 192) { Ctx Y = X; Y.bid = X.bid - 192; Y.G = X.G - 192; phase_prep(Y, l, 2, wo); } }
        SEAM(pb + 1);
        if (EN(2) && IN(pb + 2)) _Pragma("unroll 1") for (int rep = 0; rep < REPS(2); ++rep) { phase_lruconv(X, l); if (hi - lo > 1) split_arrive((unsigned*)(ws + WS_BAR), 8 + l); else __syncthreads(); phase_na(X, l, !lastl); }
        if (!(hi - lo > 1)) SEAM(pb + 2);
        if (EN(3) && IN(pb + 3)) _Pragma("unroll 1") for (int rep = 0; rep < REPS(3); ++rep) {
            if (hi - lo > 1) { split_wait((unsigned*)(ws + WS_BAR), 8 + l, (unsigned)X.G); __syncthreads(); }
#ifndef PH3SUB
#define PH3SUB 7
#endif
#ifdef NO_GROUP3
            if (PH3SUB & 1) { EpiGates E{ws, p.lru_b_a + l * 2048, p.lru_b_x + l * 2048, (const float*)(ws + WS_SP8) + l * 2048};
              run_gemm(X, (const bf16_t*)(ws + WS_U), 1024, (const bf16_t*)(ws + WS_WGATE + wo), 256, 4096, 256, E, 0, 7, 1, 256); }
            if (PH3SUB & 2) { EpiQup E{ws, rope}; run_gemm(X, (const bf16_t*)(ws + WS_CQ), 512, (const bf16_t*)(ws + WS_WQ + wo), 512, 1536, 512, E); }
            if (PH3SUB & 4) { EpiKVup E{ws}; run_gemm(X, (const bf16_t*)(ws + WS_CKV), 256, (const bf16_t*)(ws + WS_WKV + wo), 256, 2048, 256, E); }
#else
            {
                EpiGates Eg{ws, p.lru_b_a + l * 2048, p.lru_b_x + l * 2048, (const float*)(ws + WS_SP8) + l * 2048}; EpiQup Eq{ws, rope}; EpiKVup Ek{ws};
                int Gq = X.G, Bq = X.bid, k4 = 4, k8 = 8; asm volatile("" : "+s"(Gq), "+s"(Bq), "+s"(k4), "+s"(k8));
                pg8::G3 g0{(const bf16_t*)(ws + WS_U), (const bf16_t*)(ws + WS_WGATE + wo), 1024, 256, 16, k4, 7, 1, 256};
                pg8::G3 g1{(const bf16_t*)(ws + WS_CQ), (const bf16_t*)(ws + WS_WQ + wo), 512, 512, 6, k8, 0, 0, 0};
                pg8::G3 g2{(const bf16_t*)(ws + WS_CKV), (const bf16_t*)(ws + WS_WKV + wo), 256, 256, 8, k4, 0, 0, 0};
                __syncthreads();
                pg8::gemm_phase3(X.lds_las(), g0, g1, g2, Gq, Bq, Eg, Eq, Ek);
            }
#endif
        }
        SEAM(pb + 3);
        if (EN(4) && IN(pb + 4)) _Pragma("unroll 1") for (int rep = 0; rep < REPS(4); ++rep) {
#if defined(PROBE_SKIP)
            if (rep == 0) { phase_mla<0>(X, !lastl); __syncthreads(); phase_scan2(X, l); } else phase_mla<PROBE_SKIP>(X, !lastl);
#else
            phase_mla<0>(X, !lastl); __syncthreads(); phase_scan2(X, l);
#endif
        }
        SEAM(pb + 4);
        if (EN(6) && IN(pb + 6)) _Pragma("unroll 1") for (int rep = 0; rep < REPS(6); ++rep) {
            { EpiMergeF E{ws}; run_gemm(X, (const bf16_t*)(ws + WS_BR), 3072, (const bf16_t*)(ws + WS_WBR + wo), 3072, 2048, 3072, E, lastl ? 1 : 0); }
            if (early && !lastl && X.bid >= 32) { Ctx Y = X; Y.bid = X.bid - 32; Y.G = X.G - 32; if (hi - lo > 1) phase_swreduce(Y, 1, l & 1); phase_prep(Y, l + 1, 1, (size_t)((l + 1) & 1) * WSET_BYTES); }
        }
        SEAM(pb + 6);
        if (EN(7) && IN(pb + 7)) _Pragma("unroll 1") for (int rep = 0; rep < REPS(7); ++rep) { if ((hi - lo > 1) && !(early && !lastl)) phase_swreduce(X, 1, l & 1); EpiResid E{ws, l * 5 * 12288 + 2 * 2048, p.norm_ffn + l * 2048, l * 5 * 12288 + 4 * 2048, 2 * l + 1}; run_gemm(X, (const bf16_t*)(ws + WS_YMB), 2048, (const bf16_t*)(ws + WS_WOUT + wo), 2048, 2048, 2048, E, lastl ? 1 : 2); }
        SEAM(pb + 7);
        if (EN(8) && IN(pb + 8)) _Pragma("unroll 1") for (int rep = 0; rep < REPS(8); ++rep) { if (!lastl) phase_norm(X, l, p.norm_ffn + l * 2048, 3, rep == 0 ? 1 : 0, l * 5 * 12288 + 2 * 2048, (l == 0 && rep == 0) ? 1 : 0, 2 * l + 1, 1); if (hi - lo > 1) { if (!lastl) split_arrive((unsigned*)(ws + WS_BAR), 2 * l + 1); } else phase_swreduce(X, 1, l & 1); }
        if (!(hi - lo > 1)) SEAM(pb + 8);
        if (EN(9) && IN(pb + 9)) _Pragma("unroll 1") for (int rep = 0; rep < REPS(9); ++rep) { EpiFfnUp E{ws, p.ffn_conv_w + (size_t)l * 3 * DFF2, p.ffn_conv_b + (size_t)l * DFF2, X.lds, RowScale{ws + WS_SSQ + (size_t)(2 * l + 1) * TT * 8, (const float*)(ws + WS_SW) + 5 * 12288, (unsigned*)(ws + WS_BAR), (!lastl && hi - lo > 1) ? 2 * l + 1 : -1, (unsigned)X.G}}; run_gemm(X, (const bf16_t*)(ws + WS_H), 2048, (const bf16_t*)(ws + WS_WUP + wo), 2048, DFF2, 2048, E, lastl ? 1 : ((hi - lo > 1) ? 3 : 0));
            if (!lastl && early && (hi - lo > 1) && X.bid >= 176) { Ctx Y = X; Y.bid = X.bid - 176; Y.G = X.G - 176; phase_swreduce(Y, 0, (l + 1) & 1); phase_prep(Y, l + 1, 4, (size_t)((l + 1) & 1) * WSET_BYTES); } }
        SEAM(pb + 9);
        if (EN(10) && IN(pb + 10)) _Pragma("unroll 1") for (int rep = 0; rep < REPS(10); ++rep) { phase_ffnfix(X, l); }
        SEAM(pb + 10);
        if (EN(11) && IN(pb + 11)) _Pragma("unroll 1") for (int rep = 0; rep < REPS(11); ++rep) { EpiResid E{ws, l * 5 * 12288 + 5 * 2048, lastl ? (const float*)nullptr : p.norm_mix + (l + 1) * 2048, (l + 1) * 5 * 12288 + 1 * 2048, 2 * (l + 1)}; run_gemm(X, (const bf16_t*)(ws + WS_ACT), DFF, (const bf16_t*)(ws + WS_WDOWN + wo), DFF, 2048, DFF, E, lastl ? 1 : 2); }
        SEAM(pb + 11);
    }
    if (EN(13) && IN(N_PHASES - 1)) phase_final(X);
#undef IN
#undef SEAM
}

extern "C" void kernel_launch(void* const* d_in, const int* in_sizes, int n_in, void* d_out, int out_size, void* d_ws, size_t ws_size, hipStream_t stream) {
    static int grid = 0;
    if (grid == 0) {
        if (n_in != 28 || ws_size < WS_END) { fprintf(stderr, "kernel_launch: need 28 inputs and >= %zu bytes of workspace; got %d, %zu\n", (size_t)WS_END, n_in, ws_size); grid = -1; return; }
        int dev = 0, cus = 0, per_cu = 0;
        if (hipGetDevice(&dev) != hipSuccess || hipDeviceGetAttribute(&cus, hipDeviceAttributeMultiprocessorCount, dev) != hipSuccess) { grid = -1; return; }
        if (hipFuncSetAttribute((const void*)fwd_kernel, hipFuncAttributeMaxDynamicSharedMemorySize, LDS_BYTES) != hipSuccess) { fprintf(stderr, "kernel_launch: hipFuncSetAttribute failed\n"); grid = -1; return; }
        if (hipOccupancyMaxActiveBlocksPerMultiprocessor(&per_cu, (const void*)fwd_kernel, NTHR, LDS_BYTES) != hipSuccess || per_cu < 1) { fprintf(stderr, "kernel_launch: occupancy query says %d\n", per_cu); }
        (void)hipGetLastError();
        grid = cus;
    }
    if (grid < 0) return;
    (void)hipMemsetAsync((char*)d_ws + WS_BAR, 0, 16384, stream);
    Params p{};
    const float** pin = (const float**)&p;
    for (int i = 0; i < 28; ++i) pin[i] = (const float*)d_in[i];
    p.out = (float*)d_out; p.ws = (unsigned char*)d_ws;
#if MK_SINGLE
    p.ph_lo = 0; p.ph_hi = N_PHASES;
    hipLaunchKernelGGL(fwd_kernel, dim3(grid), dim3(NTHR), LDS_BYTES, stream, p);
#else
    for (int k = 0; k < N_PHASES; ++k) { p.ph_lo = k; p.ph_hi = k + 1; hipLaunchKernelGGL(fwd_kernel, dim3(grid), dim3(NTHR), LDS_BYTES, stream, p); }
#endif
    const hipError_t le = hipPeekAtLastError();
    if (le != hipSuccess) fprintf(stderr, "kernel_launch: launch failed: %s\n", hipGetErrorName(le));
}
```

```cpp
#include <hip/hip_runtime.h>
#include <stdint.h>
#include <stdio.h>

#ifndef MK_SINGLE
#define MK_SINGLE 1
#endif

#define LAS __attribute__((address_space(3)))
typedef unsigned short bf16_t;
typedef short bf16x8 __attribute__((ext_vector_type(8)));
typedef short s16x4 __attribute__((ext_vector_type(4)));
typedef float f32x2 __attribute__((ext_vector_type(2)));
typedef float f32x4 __attribute__((ext_vector_type(4)));
typedef float f32x16 __attribute__((ext_vector_type(16)));
typedef unsigned u32x2 __attribute__((ext_vector_type(2)));
typedef unsigned u32x4 __attribute__((ext_vector_type(4)));

constexpr int DM = 2048, NB = 4, SEQ = 4096, CTXL = 256, DEPTH = 4;
constexpr int SEGT = SEQ + CTXL;
constexpr int TT = NB * SEGT;
constexpr int PAN = SEGT / 256;
constexpr int DIN_SRC = 12096, DIN = 12288;
constexpr int DFF = 5632, DFF2 = 11264;
constexpr int NTHR = 512;
constexpr float EPS = 1e-6f;
constexpr int KSPLIT = 8;

constexpr int C_QKV = 0, C_LX = 3072, C_LG = 4096, C_CQ = 5120, C_CKV = 5632, C_KR = 5888, C_SG = 6144;

constexpr size_t al256(size_t x) { return (x + 255) & ~(size_t)255; }
constexpr size_t WS_BAR = 0;
constexpr size_t WS_MOD = 16384;
constexpr size_t WS_ROPE = WS_MOD + al256((size_t)DEPTH * 5 * 12288 * 4);
constexpr size_t WS_SP8 = WS_ROPE + al256((size_t)2 * 4096 * 32 * 4);
constexpr size_t WS_HLX = WS_SP8 + al256((size_t)DEPTH * 2 * 1024 * 4);
constexpr size_t WS_SSQ = WS_HLX + al256((size_t)NB * PAN * 6 * 1024 * 4);
constexpr size_t WS_SWP = WS_SSQ + al256((size_t)8 * TT * 8);
constexpr size_t WS_SW = WS_SWP + al256((size_t)2 * 2 * 16 * 5 * 12288 * 4);
constexpr size_t WS_XS = WS_SW + al256((size_t)2 * 5 * 12288 * 4);
constexpr size_t WS_H = WS_XS + (size_t)TT * DM * 4;
constexpr size_t WS_WIN = WS_H + (size_t)TT * DM * 2;
constexpr size_t WS_WGATE = WS_WIN + (size_t)DIN * DM * 2;
constexpr size_t WS_WQ = WS_WGATE + (size_t)4096 * 256 * 2;
constexpr size_t WS_WKV = WS_WQ + (size_t)1536 * 512 * 2;
constexpr size_t WS_WBR = WS_WKV + (size_t)2048 * 256 * 2;
constexpr size_t WS_WOUT = WS_WBR + (size_t)3 * 2048 * 1024 * 2;
constexpr size_t WS_WUP = WS_WOUT + (size_t)2048 * 2048 * 2;
constexpr size_t WS_WDOWN = WS_WUP + (size_t)DFF2 * DM * 2;
constexpr size_t WSET_BYTES = WS_WDOWN + (size_t)DM * DFF * 2 - WS_WIN;
constexpr size_t WS_ARENA = WS_WIN + 2 * WSET_BYTES;
constexpr size_t WS_QKV = WS_ARENA;
constexpr size_t WS_LX = WS_QKV + (size_t)TT * 3072 * 2;
constexpr size_t WS_U = WS_LX + (size_t)TT * 1024 * 2;
constexpr size_t WS_LG = WS_U + (size_t)TT * 1024 * 2;
constexpr size_t WS_CQ = WS_LG + (size_t)TT * 1024 * 2;
constexpr size_t WS_CKV = WS_CQ + (size_t)TT * 512 * 2;
constexpr size_t WS_RSQ = WS_CKV + (size_t)TT * 256 * 2;
constexpr size_t WS_RSKV = WS_RSQ + al256((size_t)TT * 4);
constexpr size_t WS_SG = WS_RSKV + al256((size_t)TT * 4);
constexpr size_t WS_KM = WS_SG + (size_t)TT * 6144;
constexpr size_t WS_VM = WS_KM + (size_t)TT * 1536 * 2;
constexpr size_t WS_QM = WS_VM + (size_t)TT * 1024 * 2;
constexpr size_t WS_BR = WS_QM + (size_t)TT * 1536 * 2;
constexpr size_t WS_PS = WS_BR + (size_t)TT * 3072 * 2;
constexpr size_t WS_AB = WS_PS + al256((size_t)2 * NB * 2 * 68 * 1024 * 4);
constexpr size_t WS_PART = WS_AB;
constexpr size_t WS_DELTA = WS_ARENA;
constexpr size_t WS_YMB = WS_AB + (size_t)2 * TT * 1024 * 4;
constexpr size_t WS_MIX_END = WS_AB + (size_t)4 * TT * 1024 * 4;
constexpr size_t WS_PF = WS_ARENA;
constexpr size_t WS_ACT = WS_PF + (size_t)TT * DFF2 * 2;
constexpr size_t WS_HALO = WS_ARENA + ((size_t)160 << 20);
constexpr size_t WS_FFN_END = WS_ACT + (size_t)TT * DFF * 2;
constexpr size_t WS_END = WS_MIX_END > WS_FFN_END ? WS_MIX_END : WS_FFN_END;

constexpr int LDS_STAGE = 131072;
constexpr int LDS_TAB = LDS_STAGE;
constexpr int LDS_BARW = LDS_STAGE + 2048;
constexpr int LDS_EXCH = LDS_STAGE + 2048 + 64;
constexpr int LDS_PF = LDS_EXCH + 12288;
constexpr int LDS_CW = LDS_PF + 6144;
constexpr int LDS_BYTES = LDS_CW + 8192;

struct Params {
    const float *x, *c, *ctx, *c_ctx, *w_mod, *b_mod, *norm_mix, *norm_ffn, *w_in, *na_rpb, *lru_conv_w, *lru_conv_b,
        *lru_w_a, *lru_b_a, *lru_w_x, *lru_b_x, *lru_lam, *mla_q_norm, *mla_kv_norm, *mla_w_q_up, *mla_w_kv_up,
        *w_branch, *w_out, *ffn_w_up, *ffn_conv_w, *ffn_conv_b, *ffn_w_down, *norm_final;
    float* out; unsigned char* ws;
    int ph_lo, ph_hi;
};

__device__ __forceinline__ unsigned cvt_pk_bf16(float lo, float hi) { unsigned r; asm("v_cvt_pk_bf16_f32 %0, %1, %2" : "=v"(r) : "v"(lo), "v"(hi)); return r; }
__device__ __forceinline__ float bflo(unsigned w) { return __uint_as_float(w << 16); }
__device__ __forceinline__ float bfhi(unsigned w) { return __uint_as_float(w & 0xffff0000u); }
__device__ __forceinline__ float bf2f(bf16_t v) { return __uint_as_float(((unsigned)v) << 16); }
__device__ __forceinline__ bf16_t f2bf(float f) { return (bf16_t)(cvt_pk_bf16(f, 0.f) & 0xffffu); }
typedef _Float16 h16x2 __attribute__((ext_vector_type(2)));
__device__ __forceinline__ unsigned pack_h2(float a, float b) { h16x2 v; v.x = (_Float16)a; v.y = (_Float16)b; return __builtin_bit_cast(unsigned, v); }
__device__ __forceinline__ float h2lo(unsigned w) { return (float)__builtin_bit_cast(h16x2, w).x; }
__device__ __forceinline__ float h2hi(unsigned w) { return (float)__builtin_bit_cast(h16x2, w).y; }
__device__ __forceinline__ float fast_exp(float x) { return __builtin_amdgcn_exp2f(x * 1.4426950408889634f); }
__device__ __forceinline__ float fast_sigmoid(float x) { return __builtin_amdgcn_rcpf(1.f + fast_exp(-x)); }
__device__ __forceinline__ float gelu_tanh(float x) { const float u = 0.7978845608028654f * (x + 0.044715f * x * x * x); return x * fast_sigmoid(2.f * u); }
__device__ __forceinline__ float silu_f(float x) { return x * fast_sigmoid(x); }
__device__ __forceinline__ float wave_sum(float v) {
#pragma unroll
    for (int o = 32; o > 0; o >>= 1) v += __shfl_xor(v, o, 64);
    return v;
}
__device__ __forceinline__ int row_batch(int r) { return r / SEGT; }

#define XB_TMO      128
#define XB_XCNT(j)  (256  + 64 * (j))
#define XB_XSUB(j)  (1280 + 64 * (j))
#define XB_XGEN(j)  (2304 + 64 * (j))
#define XB_TOP      3328
#define XB_TOPGEN   3392
#define XCD_BAR_WORDS 3456
#define XB_SPIN_CAP (1u << 22)
__device__ __forceinline__ unsigned xb_ld(unsigned* p)              { return __hip_atomic_load(p, __ATOMIC_RELAXED, __HIP_MEMORY_SCOPE_AGENT); }
__device__ __forceinline__ unsigned xb_add(unsigned* p, unsigned v) { return __hip_atomic_fetch_add(p, v, __ATOMIC_RELAXED, __HIP_MEMORY_SCOPE_AGENT); }
__device__ __forceinline__ unsigned xb_xcc_id() { return (unsigned)__builtin_amdgcn_s_getreg((3 << 11) | 20) & 0xFu; }
#define XB_SPIN(cond, bar) do { unsigned _sp = 0; while (cond) { __builtin_amdgcn_s_sleep(1); \
    if ((++_sp & 255u) == 0u) { if (xb_ld(&(bar)[XB_TMO])) break; if (_sp > XB_SPIN_CAP) { atomicAdd(&(bar)[XB_TMO], 1u); break; } } } } while (0)
struct XcdBarrier { unsigned* bar; unsigned x; volatile LAS unsigned* st; };
__device__ __forceinline__ XcdBarrier xcd_barrier_post(unsigned* bar, volatile LAS unsigned* st) {
    XcdBarrier b; b.bar = bar; b.x = xb_xcc_id(); b.st = st;
    if (threadIdx.x == 0) (void)xb_add(&bar[XB_XCNT(b.x)], 1u);
    return b;
}
__device__ __forceinline__ void xcd_barrier_complete(unsigned* bar, unsigned x, unsigned& nloc, unsigned& nx) {
    const unsigned G = gridDim.x * gridDim.y * gridDim.z;
    unsigned sum, cnt, mine, sp = 0u;
    for (;;) {
        sum = 0u; cnt = 0u; mine = 0u;
#pragma unroll
        for (unsigned j = 0; j < 16; ++j) { const unsigned c = xb_ld(&bar[XB_XCNT(j)]); sum += c; cnt += (c > 0u) ? 1u : 0u; mine = (j == x) ? c : mine; }
        if (sum == G) break;
        __builtin_amdgcn_s_sleep(1);
        if ((++sp & 255u) == 0u) { if (xb_ld(&bar[XB_TMO])) break; if (sp > XB_SPIN_CAP) { atomicAdd(&bar[XB_TMO], 1u); break; } }
    }
    nloc = mine > 0u ? mine : 1u; nx = cnt > 0u ? cnt : 1u;
}
__device__ __forceinline__ void xcd_barrier(const XcdBarrier& b) {
    asm volatile("s_waitcnt vmcnt(0)" ::: "memory");
    __syncthreads();
    int tz_ = threadIdx.x; asm volatile("" : "+v"(tz_));
    if (tz_ == 0) {
        unsigned* bar = b.bar;
        __builtin_amdgcn_s_waitcnt(0);
        unsigned nloc = b.st[0], nx = b.st[1];
        if (nloc == 0u) { xcd_barrier_complete(bar, b.x, nloc, nx); b.st[0] = nloc; b.st[1] = nx; }
        const unsigned old = xb_add(&bar[XB_XSUB(b.x)], 1u);
        const unsigned gen = old / nloc;
        if (old + 1u == (gen + 1u) * nloc) {
            __builtin_amdgcn_fence(__ATOMIC_RELEASE, "agent");
            asm volatile("s_waitcnt vmcnt(0)" ::: "memory");
            const unsigned og = xb_add(&bar[XB_TOP], 1u);
            const unsigned tg = og / nx;
            if (og + 1u == (tg + 1u) * nx) xb_add(&bar[XB_TOPGEN], 1u);
            else XB_SPIN(xb_ld(&bar[XB_TOPGEN]) == tg, bar);
            __builtin_amdgcn_fence(__ATOMIC_ACQUIRE, "agent");
            xb_add(&bar[XB_XGEN(b.x)], 1u);
            asm volatile("s_waitcnt vmcnt(0)" ::: "memory");
        } else {
            XB_SPIN(xb_ld(&bar[XB_XGEN(b.x)]) == gen, bar);
            __builtin_amdgcn_fence(__ATOMIC_ACQUIRE, "agent");
            asm volatile("s_waitcnt vmcnt(0)" ::: "memory");
        }
    }
    __syncthreads();
}

__device__ __forceinline__ void split_arrive(unsigned* bar, int k) {
    asm volatile("s_waitcnt vmcnt(0)" ::: "memory");
    __syncthreads();
    int tz_ = threadIdx.x; asm volatile("" : "+v"(tz_));
    if (tz_ == 0) { __builtin_amdgcn_fence(__ATOMIC_RELEASE, "agent"); asm volatile("s_waitcnt vmcnt(0)" ::: "memory"); (void)xb_add(&bar[3584 + 32 * k], 1u); }
}
__device__ __forceinline__ void split_wait(unsigned* bar, int k, unsigned G) {
    int tz_ = threadIdx.x; asm volatile("" : "+v"(tz_));
    if (tz_ == 0) { XB_SPIN(xb_ld(&bar[3584 + 32 * k]) < G, bar); __builtin_amdgcn_fence(__ATOMIC_ACQUIRE, "agent"); asm volatile("s_waitcnt vmcnt(0)" ::: "memory"); }
    __builtin_amdgcn_s_barrier();
}

namespace pg8 {
constexpr int BM = 256, BK = 64, HALF = 128, HTB = HALF * BK * 2, STAGE_BYTES = 8 * HTB, NXCD = 8, WGM = 8;
__host__ __device__ __forceinline__ int lds_byte(int r, int c) { const int st = (r >> 4) * 2 + (c >> 5), rr = r & 15, cc = c & 31, ob = rr * 64 + cc * 2; return st * 1024 + (ob ^ (((ob >> 9) & 1) << 5)); }
__host__ __device__ __forceinline__ void stage_rc(int b, int& R, int& C) { const int st = b / 1024, sb = b % 1024, swz = sb ^ (((sb >> 9) & 1) << 5); R = (st >> 1) * 16 + swz / 64; C = (st & 1) * 32 + (swz % 64) / 2; }
__host__ __device__ __forceinline__ int perm32(int rho) { const int n = rho >> 4, i = rho & 15; return 8 * (i >> 2) + 4 * n + (i & 3); }
struct Unit { int pm, pn, k0, nk, split, par; };
struct Gemm { const bf16_t* A; int lda; const bf16_t* Bt; int ldb; int M, N, K; int amask, ashift, astep; };
struct Order {
    int nM, nN, nwg, G, c, nkt, mode, S;
    __device__ void init(int N, int K, int G_, int c_, int mode_, int S_) { mode = mode_; S = S_; nM = mode == 0 ? NB * PAN : NB * 16; nN = N / BM; nwg = nM * nN; G = G_; c = c_; nkt = K / BK; }
    __device__ bool next(int i, Unit& u) const {
        const long L = (long)i * G + c;
        if (L < nwg) {
            int wgid = (int)L; { const int q = nwg / NXCD, r = nwg % NXCD, xcd = wgid % NXCD, off = wgid / NXCD; wgid = (xcd < r ? xcd * (q + 1) : r * (q + 1) + (xcd - r) * q) + off; }
            const int nig = WGM * nN, gid = wgid / nig, fm = gid * WGM, gsz = (nM - fm) < WGM ? (nM - fm) : WGM;
            const int pml = fm + ((wgid % nig) % gsz); u.pn = (wgid % nig) / gsz;
            u.pm = mode == 0 ? pml : (pml >> 4) * PAN + 1 + (pml & 15);
            u.k0 = 0; u.nk = nkt; u.split = 0; return true;
        }
        if (mode == 3) {
            const long L2 = L - nwg; if (L2 >= (long)NB * nN) return false;
            u.pm = ((int)L2 / nN) * PAN; u.pn = (int)L2 % nN; u.k0 = 0; u.nk = nkt; u.split = 0; return true;
        }
        if (mode == 2) {
            const long L2 = L - nwg; if (L2 >= (long)NB * nN * S) return false;
            const int tq = (int)L2 / S, sl = (int)L2 % S; u.pm = (tq / nN) * PAN; u.pn = tq % nN;
            const int pairs = nkt >> 1, base = pairs / S, rem = pairs % S;
            u.k0 = 2 * (sl * base + (sl < rem ? sl : rem)); u.nk = 2 * (base + (sl < rem ? 1 : 0)); u.split = 1 + sl; return true;
        }
        return false;
    }
};

template <class E, class = void> struct HasPref { static constexpr bool v = false; };
template <class E> struct HasPref<E, decltype((void)E::PREF)> { static constexpr bool v = E::PREF; };
template <class E, class = void> struct HasCtxWait { static constexpr bool v = false; };
template <class E> struct HasCtxWait<E, decltype((void)E::CTXWAIT)> { static constexpr bool v = E::CTXWAIT; };
template <class E, class = void> struct HasAperm { static constexpr bool v = false; };
template <class E> struct HasAperm<E, decltype((void)E::APERM)> { static constexpr bool v = E::APERM; };
template <class Epi>
__device__ __forceinline__ void gemm_phase(LAS unsigned char* lds, const Gemm g, const Order& S, const Epi& E) {
    int tid = threadIdx.x; asm volatile("" : "+v"(tid));
    const int wid = __builtin_amdgcn_readfirstlane(tid >> 6), lane = tid & 63, wr = wid >> 2, wc = wid & 3, fr = lane & 15, fq = lane >> 4;
    unsigned voffA[2], voffB[2];
#pragma unroll
    for (int i = 0; i < 2; ++i) { int R, C; stage_rc(tid * 16 + i * 8192, R, C); const int Rb = Epi::PERM ? ((R & ~31) + perm32(R & 31)) : R;
        const int Ra = HasAperm<Epi>::v ? ((R & ~63) + 4 * (R & 15) + ((R >> 4) & 3)) : R;
        voffA[i] = (unsigned)(Ra * g.lda + C) * 2u; voffB[i] = (unsigned)(Rb * g.ldb + C) * 2u; }
    const size_t kstep = (size_t)(BK * 2);
    const size_t hstepA = (size_t)HALF * g.lda * 2, hstepB = (size_t)HALF * g.ldb * 2;
    const size_t tstepA = 2 * hstepA, tstepB = 2 * hstepB;
    const unsigned ldsw = (unsigned)wid * 1024u;
    const int aoff = lds_byte(wr * 64 + fr, fq * 8), boff = lds_byte(wc * 32 + fr, fq * 8);
#define PG8_SA(b, h) (((b) * 2 + (h)) * HTB)
#define PG8_SB(b, h) ((4 + (b) * 2 + (h)) * HTB)
#define PG8_STAGE(bufoff, gbase, voff) do { _Pragma("unroll") for (int _i = 0; _i < 2; ++_i) \
        __builtin_amdgcn_global_load_lds((const unsigned*)((const char*)(gbase) + (voff)[_i]), (LAS unsigned*)(lds + (bufoff) + ldsw + _i * 8192), 16, 0, 0); } while (0)
#define PG8_LDA(dst, b, h) do { _Pragma("unroll") for (int m = 0; m < 4; ++m) _Pragma("unroll") for (int k = 0; k < 2; ++k) dst[m][k] = *(const LAS bf16x8*)(lds + PG8_SA(b, h) + aoff + m * 2048 + k * 1024); } while (0)
#define PG8_LDB(dst, b, h) do { _Pragma("unroll") for (int n = 0; n < 2; ++n) _Pragma("unroll") for (int k = 0; k < 2; ++k) dst[n][k] = *(const LAS bf16x8*)(lds + PG8_SB(b, h) + boff + n * 2048 + k * 1024); } while (0)
#define PG8_MMA(ai, bj, At, Bt) do { __builtin_amdgcn_s_setprio(1); _Pragma("unroll") for (int m = 0; m < 4; ++m) _Pragma("unroll") for (int n = 0; n < 2; ++n) _Pragma("unroll") for (int k = 0; k < 2; ++k) \
        acc[ai][bj][m][n] = __builtin_amdgcn_mfma_f32_16x16x32_bf16(Bt[n][k], At[m][k], acc[ai][bj][m][n], 0, 0, 0); __builtin_amdgcn_s_setprio(0); } while (0)
#define PG8_WAIT_V(n) asm volatile("s_waitcnt vmcnt(" #n ")" ::: "memory")
#define PG8_WAIT_L(n) asm volatile("s_waitcnt lgkmcnt(" #n ")" ::: "memory")
#define PG8_BAR __builtin_amdgcn_s_barrier()
#define PG8_SCHED __builtin_amdgcn_sched_barrier(0)
#define PG8_AOFF(u) ((size_t)((((u).pn & g.amask) >> g.ashift) * g.astep) * 2)
    Unit cur, nxt; int ui = 0;
    if (!S.next(0, cur)) return;
    cur.par = 0; bool waited = false; (void)waited;
    f32x4 acc[2][2][4][2];
#pragma unroll
    for (int a = 0; a < 2; ++a)
#pragma unroll
        for (int b = 0; b < 2; ++b)
#pragma unroll
            for (int m = 0; m < 4; ++m)
#pragma unroll
                for (int n = 0; n < 2; ++n) acc[a][b][m][n] = (f32x4){0.f, 0.f, 0.f, 0.f};
    bf16x8 At[4][2], B0[2][2], B1[2][2];
    const char* cA = (const char*)g.A + (size_t)cur.pm * tstepA + PG8_AOFF(cur) + (size_t)cur.k0 * kstep; const char* cB = (const char*)g.Bt + (size_t)cur.pn * tstepB + (size_t)cur.k0 * kstep;
    PG8_STAGE(PG8_SB(0, 0), cB, voffB); PG8_STAGE(PG8_SA(0, 0), cA, voffA); PG8_STAGE(PG8_SB(0, 1), cB + hstepB, voffB); PG8_STAGE(PG8_SA(0, 1), cA + hstepA, voffA);
    if (wr == 1) PG8_BAR;
    PG8_WAIT_V(4); PG8_BAR;
    PG8_STAGE(PG8_SB(1, 0), cB + kstep, voffB); PG8_STAGE(PG8_SA(1, 0), cA + kstep, voffA); PG8_STAGE(PG8_SB(1, 1), cB + hstepB + kstep, voffB);
    PG8_WAIT_V(6); PG8_BAR;
    for (;;) {
        const bool has_next = S.next(ui + 1, nxt);
        const char* nA = has_next ? (const char*)g.A + (size_t)nxt.pm * tstepA + PG8_AOFF(nxt) + (size_t)nxt.k0 * kstep : cA; const char* nB = has_next ? (const char*)g.Bt + (size_t)nxt.pn * tstepB + (size_t)nxt.k0 * kstep : cB;
        const int nt = cur.nk;
        if constexpr (HasCtxWait<Epi>::v) { if (!waited && has_next && (nxt.pm % PAN) == 0) { E.ctx_wait(); waited = true; } }
        if constexpr (HasPref<Epi>::v) E.prefetch(lds, cur, wid, tid & 63);
#pragma unroll 1
        for (int t = 0; t < nt; t += 2) {
            const bool last = (t == nt - 2);
            if constexpr (Epi::KHOOK > 0) { if (t > 0 && (t % Epi::KHOOK) == 0) E.khook(acc, cur, t / Epi::KHOOK); }
            const char* a1 = cA + (size_t)(t + 1) * kstep;
            const char* a2 = last ? nA : cA + (size_t)(t + 2) * kstep; const char* b2 = last ? nB : cB + (size_t)(t + 2) * kstep;
            const char* a3 = a2 + kstep; const char* b3 = b2 + kstep;
            PG8_LDB(B0, 0, 0); PG8_SCHED; PG8_LDA(At, 0, 0); PG8_STAGE(PG8_SA(1, 1), a1 + hstepA, voffA);
            PG8_WAIT_L(8); PG8_BAR; PG8_WAIT_L(0); PG8_MMA(0, 0, At, B0); PG8_BAR; PG8_SCHED;
            PG8_LDB(B1, 0, 1); PG8_STAGE(PG8_SB(0, 0), b2, voffB);
            PG8_BAR; PG8_WAIT_L(0); PG8_MMA(0, 1, At, B1); PG8_BAR;
            PG8_LDA(At, 0, 1); PG8_STAGE(PG8_SA(0, 0), a2, voffA);
            PG8_BAR; PG8_WAIT_L(0); PG8_MMA(1, 0, At, B0); PG8_BAR; PG8_SCHED;
            PG8_STAGE(PG8_SB(0, 1), b2 + hstepB, voffB);
            PG8_WAIT_V(6); PG8_BAR; PG8_MMA(1, 1, At, B1); PG8_BAR;
            PG8_LDB(B0, 1, 0); PG8_SCHED; PG8_LDA(At, 1, 0); PG8_STAGE(PG8_SA(0, 1), a2 + hstepA, voffA);
            PG8_WAIT_L(8); PG8_BAR; PG8_WAIT_L(0); PG8_MMA(0, 0, At, B0); PG8_BAR; PG8_SCHED;
            PG8_LDB(B1, 1, 1); PG8_STAGE(PG8_SB(1, 0), b3, voffB);
            PG8_BAR; PG8_WAIT_L(0); PG8_MMA(0, 1, At, B1); PG8_BAR;
            PG8_LDA(At, 1, 1); PG8_STAGE(PG8_SA(1, 0), a3, voffA);
            PG8_BAR; PG8_WAIT_L(0); PG8_MMA(1, 0, At, B0); PG8_BAR; PG8_SCHED;
            PG8_STAGE(PG8_SB(1, 1), b3 + hstepB, voffB);
            PG8_WAIT_V(6); PG8_BAR; PG8_MMA(1, 1, At, B1); PG8_BAR;
        }
        E(acc, cur);
        if (!has_next) break;
#pragma unroll
        for (int a = 0; a < 2; ++a)
#pragma unroll
            for (int b = 0; b < 2; ++b)
#pragma unroll
                for (int m = 0; m < 4; ++m)
#pragma unroll
                    for (int n = 0; n < 2; ++n) acc[a][b][m][n] = (f32x4){0.f, 0.f, 0.f, 0.f};
        cur = nxt; cA = nA; cB = nB; ++ui; cur.par = ui & 1;
    }
    PG8_WAIT_V(0);
    if (wr == 0) PG8_BAR;
    PG8_BAR;
#undef PG8_SA
#undef PG8_SB
#undef PG8_STAGE
#undef PG8_LDA
#undef PG8_LDB
#undef PG8_MMA
#undef PG8_WAIT_V
#undef PG8_WAIT_L
#undef PG8_BAR
#undef PG8_SCHED
#undef PG8_AOFF
}
struct G3 { const bf16_t* A; const bf16_t* B; int lda, ldb, nN, nkt, amask, ashift, astep; };
struct Unit3 { int gi, pm, pn, nk; };
__device__ __forceinline__ bool next3(long L, int n0, int n1, int n2, int nN0, int nN1, int nN2, int nk0, int nk1, int nk2, Unit3& u) {
    if (L >= (long)n0 + n1 + n2) return false;
    int loc, nN, nwg;
    if (L < n0) { u.gi = 0; loc = (int)L; nN = nN0; nwg = n0; u.nk = nk0; } else if (L < (long)n0 + n1) { u.gi = 1; loc = (int)(L - n0); nN = nN1; nwg = n1; u.nk = nk1; } else { u.gi = 2; loc = (int)(L - n0 - n1); nN = nN2; nwg = n2; u.nk = nk2; }
    int wgid = loc; { const int q = nwg / NXCD, r = nwg % NXCD, xcd = wgid % NXCD, off = wgid / NXCD; wgid = (xcd < r ? xcd * (q + 1) : r * (q + 1) + (xcd - r) * q) + off; }
    const int nM = NB * PAN; const int nig = WGM * nN, gid = wgid / nig, fm = gid * WGM, gsz = (nM - fm) < WGM ? (nM - fm) : WGM;
    u.pm = fm + ((wgid % nig) % gsz); u.pn = (wgid % nig) / gsz; return true;
}
template <class E0, class E1, class E2>
__device__ __forceinline__ void gemm_phase3(LAS unsigned char* lds, const G3 g0, const G3 g1, const G3 g2, int G, int c, const E0& e0, const E1& e1, const E2& e2) {
    int tid = threadIdx.x; asm volatile("" : "+v"(tid));
    const int wid = __builtin_amdgcn_readfirstlane(tid >> 6), lane = tid & 63, wr = wid >> 2, wc = wid & 3, fr = lane & 15, fq = lane >> 4;
    const size_t kstep = (size_t)(BK * 2);
    const unsigned ldsw = (unsigned)wid * 1024u;
    const int aoff = lds_byte(wr * 64 + fr, fq * 8), boff = lds_byte(wc * 32 + fr, fq * 8);
    int R0, C0, R1, C1; stage_rc(tid * 16, R0, C0); stage_rc(tid * 16 + 8192, R1, C1);
    const int n0 = NB * PAN * g0.nN, n1 = NB * PAN * g1.nN, n2 = NB * PAN * g2.nN;
#define G3SEL(u, f) ((u).gi == 0 ? g0.f : ((u).gi == 1 ? g1.f : g2.f))
#define G3PERM(u) ((u).gi == 0 ? E0::PERM : ((u).gi == 1 ? E1::PERM : E2::PERM))
#define G3_SETUP(u, vA, vB, hA, hB, pA, pB) do { const int _lda = G3SEL(u, lda), _ldb = G3SEL(u, ldb); const bool _pm = G3PERM(u); \
        const int _Rb0 = _pm ? ((R0 & ~31) + perm32(R0 & 31)) : R0, _Rb1 = _pm ? ((R1 & ~31) + perm32(R1 & 31)) : R1; \
        const int _Ra0 = ((u).gi == 0 && E0::APERM) ? ((R0 & ~63) + 4 * (R0 & 15) + ((R0 >> 4) & 3)) : R0, _Ra1 = ((u).gi == 0 && E0::APERM) ? ((R1 & ~63) + 4 * (R1 & 15) + ((R1 >> 4) & 3)) : R1; \
        vA[0] = (unsigned)(_Ra0 * _lda + C0) * 2u; vA[1] = (unsigned)(_Ra1 * _lda + C1) * 2u; vB[0] = (unsigned)(_Rb0 * _ldb + C0) * 2u; vB[1] = (unsigned)(_Rb1 * _ldb + C1) * 2u; \
        hA = (size_t)HALF * _lda * 2; hB = (size_t)HALF * _ldb * 2; \
        pA = (const char*)G3SEL(u, A) + (size_t)(u).pm * 2 * hA + (size_t)((((u).pn & G3SEL(u, amask)) >> G3SEL(u, ashift)) * G3SEL(u, astep)) * 2; \
        pB = (const char*)G3SEL(u, B) + (size_t)(u).pn * 2 * hB; } while (0)
#define PG8_SA(b, h) (((b) * 2 + (h)) * HTB)
#define PG8_SB(b, h) ((4 + (b) * 2 + (h)) * HTB)
#define PG8_STAGE(bufoff, gbase, voff) do { _Pragma("unroll") for (int _i = 0; _i < 2; ++_i) \
        __builtin_amdgcn_global_load_lds((const unsigned*)((const char*)(gbase) + (voff)[_i]), (LAS unsigned*)(lds + (bufoff) + ldsw + _i * 8192), 16, 0, 0); } while (0)
#define PG8_LDA(dst, b, h) do { _Pragma("unroll") for (int m = 0; m < 4; ++m) _Pragma("unroll") for (int k = 0; k < 2; ++k) dst[m][k] = *(const LAS bf16x8*)(lds + PG8_SA(b, h) + aoff + m * 2048 + k * 1024); } while (0)
#define PG8_LDB(dst, b, h) do { _Pragma("unroll") for (int n = 0; n < 2; ++n) _Pragma("unroll") for (int k = 0; k < 2; ++k) dst[n][k] = *(const LAS bf16x8*)(lds + PG8_SB(b, h) + boff + n * 2048 + k * 1024); } while (0)
#define PG8_MMA(ai, bj, At, Bt) do { __builtin_amdgcn_s_setprio(1); _Pragma("unroll") for (int m = 0; m < 4; ++m) _Pragma("unroll") for (int n = 0; n < 2; ++n) _Pragma("unroll") for (int k = 0; k < 2; ++k) \
        acc[ai][bj][m][n] = __builtin_amdgcn_mfma_f32_16x16x32_bf16(Bt[n][k], At[m][k], acc[ai][bj][m][n], 0, 0, 0); __builtin_amdgcn_s_setprio(0); } while (0)
#define PG8_WAIT_V(n) asm volatile("s_waitcnt vmcnt(" #n ")" ::: "memory")
#define PG8_WAIT_L(n) asm volatile("s_waitcnt lgkmcnt(" #n ")" ::: "memory")
#define PG8_BAR __builtin_amdgcn_s_barrier()
#define PG8_SCHED __builtin_amdgcn_sched_barrier(0)
    Unit3 cur, nxt; int ui = 0;
    if (!next3((long)c, n0, n1, n2, g0.nN, g1.nN, g2.nN, g0.nkt, g1.nkt, g2.nkt, cur)) return;
    f32x4 acc[2][2][4][2];
#pragma unroll
    for (int a = 0; a < 2; ++a)
#pragma unroll
        for (int b = 0; b < 2; ++b)
#pragma unroll
            for (int m = 0; m < 4; ++m)
#pragma unroll
                for (int n = 0; n < 2; ++n) acc[a][b][m][n] = (f32x4){0.f, 0.f, 0.f, 0.f};
    bf16x8 At[4][2], B0[2][2], B1[2][2];
    unsigned vAc[2], vBc[2], vAn[2], vBn[2]; size_t hAc, hBc, hAn, hBn; const char *cA, *cB, *nA, *nB;
    G3_SETUP(cur, vAc, vBc, hAc, hBc, cA, cB);
    PG8_STAGE(PG8_SB(0, 0), cB, vBc); PG8_STAGE(PG8_SA(0, 0), cA, vAc); PG8_STAGE(PG8_SB(0, 1), cB + hBc, vBc); PG8_STAGE(PG8_SA(0, 1), cA + hAc, vAc);
    if (wr == 1) PG8_BAR;
    PG8_WAIT_V(4); PG8_BAR;
    PG8_STAGE(PG8_SB(1, 0), cB + kstep, vBc); PG8_STAGE(PG8_SA(1, 0), cA + kstep, vAc); PG8_STAGE(PG8_SB(1, 1), cB + hBc + kstep, vBc);
    PG8_WAIT_V(6); PG8_BAR;
    for (;;) {
        const bool has_next = next3((long)(ui + 1) * G + c, n0, n1, n2, g0.nN, g1.nN, g2.nN, g0.nkt, g1.nkt, g2.nkt, nxt);
        if (has_next) { G3_SETUP(nxt, vAn, vBn, hAn, hBn, nA, nB); } else { vAn[0] = vAc[0]; vAn[1] = vAc[1]; vBn[0] = vBc[0]; vBn[1] = vBc[1]; hAn = hAc; hBn = hBc; nA = cA; nB = cB; }
        const int nt = cur.nk;
#pragma unroll 1
        for (int t = 0; t < nt; t += 2) {
            const bool last = (t == nt - 2);
            const char* a1 = cA + (size_t)(t + 1) * kstep;
            const char* a2 = last ? nA : cA + (size_t)(t + 2) * kstep; const char* b2 = last ? nB : cB + (size_t)(t + 2) * kstep;
            const char* a3 = a2 + kstep; const char* b3 = b2 + kstep;
            unsigned vA2[2], vB2[2]; vA2[0] = last ? vAn[0] : vAc[0]; vA2[1] = last ? vAn[1] : vAc[1]; vB2[0] = last ? vBn[0] : vBc[0]; vB2[1] = last ? vBn[1] : vBc[1];
            const size_t hA2 = last ? hAn : hAc, hB2 = last ? hBn : hBc;
            PG8_LDB(B0, 0, 0); PG8_SCHED; PG8_LDA(At, 0, 0); PG8_STAGE(PG8_SA(1, 1), a1 + hAc, vAc);
            PG8_WAIT_L(8); PG8_BAR; PG8_WAIT_L(0); PG8_MMA(0, 0, At, B0); PG8_BAR; PG8_SCHED;
            PG8_LDB(B1, 0, 1); PG8_STAGE(PG8_SB(0, 0), b2, vB2);
            PG8_BAR; PG8_WAIT_L(0); PG8_MMA(0, 1, At, B1); PG8_BAR;
            PG8_LDA(At, 0, 1); PG8_STAGE(PG8_SA(0, 0), a2, vA2);
            PG8_BAR; PG8_WAIT_L(0); PG8_MMA(1, 0, At, B0); PG8_BAR; PG8_SCHED;
            PG8_STAGE(PG8_SB(0, 1), b2 + hB2, vB2);
            PG8_WAIT_V(6); PG8_BAR; PG8_MMA(1, 1, At, B1); PG8_BAR;
            PG8_LDB(B0, 1, 0); PG8_SCHED; PG8_LDA(At, 1, 0); PG8_STAGE(PG8_SA(0, 1), a2 + hA2, vA2);
            PG8_WAIT_L(8); PG8_BAR; PG8_WAIT_L(0); PG8_MMA(0, 0, At, B0); PG8_BAR; PG8_SCHED;
            PG8_LDB(B1, 1, 1); PG8_STAGE(PG8_SB(1, 0), b3, vB2);
            PG8_BAR; PG8_WAIT_L(0); PG8_MMA(0, 1, At, B1); PG8_BAR;
            PG8_LDA(At, 1, 1); PG8_STAGE(PG8_SA(1, 0), a3, vA2);
            PG8_BAR; PG8_WAIT_L(0); PG8_MMA(1, 0, At, B0); PG8_BAR; PG8_SCHED;
            PG8_STAGE(PG8_SB(1, 1), b3 + hB2, vB2);
            PG8_WAIT_V(6); PG8_BAR; PG8_MMA(1, 1, At, B1); PG8_BAR;
        }
        { Unit u; u.pm = cur.pm; u.pn = cur.pn; u.k0 = 0; u.nk = cur.nk; u.split = 0;
          if (cur.gi == 0) e0(acc, u); else if (cur.gi == 1) e1(acc, u); else e2(acc, u); }
        if (!has_next) break;
#pragma unroll
        for (int a = 0; a < 2; ++a)
#pragma unroll
            for (int b = 0; b < 2; ++b)
#pragma unroll
                for (int m = 0; m < 4; ++m)
#pragma unroll
                    for (int n = 0; n < 2; ++n) acc[a][b][m][n] = (f32x4){0.f, 0.f, 0.f, 0.f};
        cur = nxt; cA = nA; cB = nB; vAc[0] = vAn[0]; vAc[1] = vAn[1]; vBc[0] = vBn[0]; vBc[1] = vBn[1]; hAc = hAn; hBc = hBn; ++ui;
    }
    PG8_WAIT_V(0);
    if (wr == 0) PG8_BAR;
    PG8_BAR;
#undef G3SEL
#undef G3PERM
#undef G3_SETUP
#undef PG8_SA
#undef PG8_SB
#undef PG8_STAGE
#undef PG8_LDA
#undef PG8_LDB
#undef PG8_MMA
#undef PG8_WAIT_V
#undef PG8_WAIT_L
#undef PG8_BAR
#undef PG8_SCHED
}
}
typedef f32x4 AccT[2][2][4][2];
struct RowScale {
    const unsigned char* ssq; const float* sw;
    unsigned* sbar; int sk; unsigned sG;
    __device__ __forceinline__ void ctx_wait() const { if (sk >= 0) split_wait(sbar, sk, sG); }
    __device__ __forceinline__ void prefetch(LAS unsigned char* lds, const pg8::Unit& u, int wid, int lane) const {
        LAS unsigned char* d = lds + LDS_PF + u.par * 3072 + wid * 256;
        __builtin_amdgcn_global_load_lds((const unsigned*)((const char*)ssq + (size_t)u.pm * 2048 + wid * 256 + lane * 4), (LAS unsigned*)d, 4, 0, 0);
        if (wid < 4) { const int b = u.pm / PAN, seg = u.pm % PAN, mr = seg == 0 ? 4 : b;
            __builtin_amdgcn_global_load_lds((const unsigned*)((const char*)(sw + (size_t)mr * 12288 + u.pn * 256) + wid * 256 + lane * 4), (LAS unsigned*)(d + 2048), 4, 0, 0); }
    }
    __device__ __forceinline__ void apply(AccT& acc, const pg8::Unit& u, const char* lds, int wr, int wc, int fr, int fq) const {
        const unsigned long long* sq = (const unsigned long long*)(lds + LDS_PF + u.par * 3072) + wr * 64 + 4 * fr;
        const float* sl = (const float*)(lds + LDS_PF + u.par * 3072 + 2048) + wc * 32 + 8 * fq;
        f32x4 swv[2][2];
#pragma unroll
        for (int bj = 0; bj < 2; ++bj)
#pragma unroll
            for (int n = 0; n < 2; ++n) swv[bj][n] = *(const f32x4*)(sl + bj * 128 + 4 * n);
#pragma unroll
        for (int ai = 0; ai < 2; ++ai)
#pragma unroll
            for (int m = 0; m < 4; ++m) { const float rs = rsqrtf(__ull2float_rn(sq[ai * 128 + m]) * (1.f / (16777216.f * 2048.f)) + EPS);
#pragma unroll
                for (int bj = 0; bj < 2; ++bj)
#pragma unroll
                    for (int n = 0; n < 2; ++n) acc[ai][bj][m][n] = acc[ai][bj][m][n] * rs + swv[bj][n]; }
    }
};
#define EPI_LANES() int _tz = threadIdx.x; asm volatile("" : "+v"(_tz)); const int _wid = __builtin_amdgcn_readfirstlane(_tz >> 6); \
    const int wr = _wid >> 2, wc = _wid & 3, fr = _tz & 15, fq = (_tz >> 4) & 3;

__device__ __forceinline__ u32x4 pack8(f32x4 v0, f32x4 v1) { u32x4 w; w.x = cvt_pk_bf16(v0[0], v0[1]); w.y = cvt_pk_bf16(v0[2], v0[3]); w.z = cvt_pk_bf16(v1[0], v1[1]); w.w = cvt_pk_bf16(v1[2], v1[3]); return w; }

__device__ __forceinline__ float dpp_shr1(float old, float src) { return __int_as_float(__builtin_amdgcn_update_dpp(__float_as_int(old), __float_as_int(src), 0x111, 0xf, 0xf, false)); }
__device__ __forceinline__ float dpp_shl1(float old, float src) { return __int_as_float(__builtin_amdgcn_update_dpp(__float_as_int(old), __float_as_int(src), 0x101, 0xf, 0xf, false)); }
struct EpiInProj {
    static constexpr bool PERM = true; static constexpr int KHOOK = 0; static constexpr bool APERM = true; static constexpr bool PREF = true; static constexpr bool CTXWAIT = true;
    __device__ __forceinline__ void ctx_wait() const { rsc.ctx_wait(); }
    unsigned char* ws; const float* rope; const float* lcw; const float* lcb; char* lds; RowScale rsc;
    __device__ __forceinline__ void prefetch(LAS unsigned char* l, const pg8::Unit& u, int wid, int lane) const { rsc.prefetch(l, u, wid, lane); }
    __device__ __forceinline__ void lru_conv(const AccT& acc, const pg8::Unit& u, int wr, int wc, int fr, int fq, int cbase) const {
        float* EX = (float*)(lds + LDS_EXCH);
        if (fr == 0 || fr == 15) {
#pragma unroll
            for (int ai = 0; ai < 2; ++ai)
#pragma unroll
                for (int bj = 0; bj < 2; ++bj)
#pragma unroll
                    for (int n = 0; n < 2; ++n) {
                        float* e = EX + ((ai * 2 + wr) * 3 * 4 + wc) * 64 + ((bj * 4 + fq) * 2 + n) * 4;
                        if (fr == 0) *(f32x4*)e = acc[ai][bj][0][n];
                        else { *(f32x4*)(e + 256) = acc[ai][bj][3][n]; *(f32x4*)(e + 512) = acc[ai][bj][2][n]; }
                    }
        }
        {
            float* HL = (float*)(ws + WS_HLX) + (size_t)u.pm * 6 * 1024 + cbase + wc * 32 + 8 * fq;
            if (wr == 0 && fr == 0) {
#pragma unroll
                for (int m = 0; m < 3; ++m)
#pragma unroll
                    for (int bj = 0; bj < 2; ++bj)
#pragma unroll
                        for (int n = 0; n < 2; ++n) *(f32x4*)(HL + (size_t)m * 1024 + bj * 128 + 4 * n) = acc[0][bj][m][n];
            }
            if (wr == 1 && fr == 15) {
#pragma unroll
                for (int m = 1; m < 4; ++m)
#pragma unroll
                    for (int bj = 0; bj < 2; ++bj)
#pragma unroll
                        for (int n = 0; n < 2; ++n) *(f32x4*)(HL + (size_t)(2 + m) * 1024 + bj * 128 + 4 * n) = acc[1][bj][m][n];
            }
        }
        asm volatile("s_waitcnt lgkmcnt(0)" ::: "memory");
        __builtin_amdgcn_s_barrier();
        __builtin_amdgcn_s_barrier();
        asm volatile("" ::: "memory");
        bf16_t* U = (bf16_t*)(ws + WS_U);
        const int row0 = u.pm * 256 + wr * 64 + 4 * fr;
#pragma unroll
        for (int ai = 0; ai < 2; ++ai) {
            const int blk = ai * 2 + wr;
#pragma unroll
            for (int bj = 0; bj < 2; ++bj) {
                u32x2 outw[4][2];
#pragma unroll
                for (int n = 0; n < 2; ++n) {
                    const int c = cbase + bj * 128 + wc * 32 + 8 * fq + 4 * n;
                    const f32x4 w0 = *(const f32x4*)(lcw + c), w1 = *(const f32x4*)(lcw + 1024 + c), w2 = *(const f32x4*)(lcw + 2048 + c), w3 = *(const f32x4*)(lcw + 3072 + c), bb = *(const f32x4*)(lcb + c);
                    f32x4 t1 = {0.f, 0.f, 0.f, 0.f}, t2 = t1, b1 = t1;
                    const int eo = ((bj * 4 + fq) * 2 + n) * 4;
                    if (blk > 0) { const float* e = EX + (((blk - 1) * 3) * 4 + wc) * 64 + eo; t1 = *(const f32x4*)(e + 256); t2 = *(const f32x4*)(e + 512); }
                    if (blk < 3) { const float* e = EX + (((blk + 1) * 3) * 4 + wc) * 64 + eo; b1 = *(const f32x4*)e; }
                    f32x4 xm1, xm2, xp1;
#pragma unroll
                    for (int j = 0; j < 4; ++j) { xm1[j] = dpp_shr1(t1[j], acc[ai][bj][3][n][j]); xm2[j] = dpp_shr1(t2[j], acc[ai][bj][2][n][j]); xp1[j] = dpp_shl1(b1[j], acc[ai][bj][0][n][j]); }
                    const f32x4 x0 = acc[ai][bj][0][n], x1 = acc[ai][bj][1][n], x2 = acc[ai][bj][2][n], x3 = acc[ai][bj][3][n];
                    const f32x4 u0 = bb + w0 * xm2 + w1 * xm1 + w2 * x0 + w3 * x1;
                    const f32x4 u1 = bb + w0 * xm1 + w1 * x0 + w2 * x1 + w3 * x2;
                    const f32x4 u2 = bb + w0 * x0 + w1 * x1 + w2 * x2 + w3 * x3;
                    const f32x4 u3 = bb + w0 * x1 + w1 * x2 + w2 * x3 + w3 * xp1;
                    outw[0][n].x = cvt_pk_bf16(u0[0], u0[1]); outw[0][n].y = cvt_pk_bf16(u0[2], u0[3]); outw[1][n].x = cvt_pk_bf16(u1[0], u1[1]); outw[1][n].y = cvt_pk_bf16(u1[2], u1[3]);
                    outw[2][n].x = cvt_pk_bf16(u2[0], u2[1]); outw[2][n].y = cvt_pk_bf16(u2[2], u2[3]); outw[3][n].x = cvt_pk_bf16(u3[0], u3[1]); outw[3][n].y = cvt_pk_bf16(u3[2], u3[3]);
                }
#pragma unroll
                for (int m = 0; m < 4; ++m) { u32x4 w; w.x = outw[m][0].x; w.y = outw[m][0].y; w.z = outw[m][1].x; w.w = outw[m][1].y;
                    *(u32x4*)(U + (size_t)(row0 + ai * 128 + m) * 1024 + cbase + bj * 128 + wc * 32 + 8 * fq) = w; }
            }
        }
    }
    __device__ __forceinline__ void operator()(AccT& acc, const pg8::Unit& u) const {
        EPI_LANES();
        rsc.apply(acc, u, lds, wr, wc, fr, fq);
        const int pn = u.pn; const int seg = u.pm % PAN;
        bf16_t* dst; int ld, cbase; int mode;
        if (pn < 12) { dst = (bf16_t*)(ws + WS_QKV); ld = 3072; cbase = pn * 256; mode = 0; }
        else if (pn < 16) { dst = (bf16_t*)(ws + WS_U); ld = 1024; cbase = (pn - 12) * 256; mode = 4; }
        else if (pn < 20) { dst = (bf16_t*)(ws + WS_LG); ld = 1024; cbase = (pn - 16) * 256; mode = 1; }
        else if (pn < 22) { dst = (bf16_t*)(ws + WS_CQ); ld = 512; cbase = (pn - 20) * 256; mode = 0; }
        else if (pn < 23) { dst = (bf16_t*)(ws + WS_CKV); ld = 256; cbase = 0; mode = 0; }
        else if (pn < 24) { dst = (bf16_t*)(ws + WS_KM); ld = 1536; cbase = 0; mode = 3; }
        else { dst = nullptr; ld = 6144; cbase = (pn - 24) * 256; mode = 2; }
        const int row0 = u.pm * 256 + wr * 64 + 4 * fr;
        if (mode == 4) { lru_conv(acc, u, wr, wc, fr, fq, cbase); return; }
        if (mode == 3) {
            if (wc >= 2) return;
            const int cl = wc * 32 + 8 * fq;
            f32x4 csv[8], snv[8];
#pragma unroll
            for (int q = 0; q < 8; ++q) { const int pos = seg != 0 ? (seg - 1) * 256 + (wr * 64 + 4 * fr + (q >> 2) * 128 + (q & 3)) : 0;
                csv[q] = *(const f32x4*)(rope + (size_t)pos * 32 + (cl >> 1)); snv[q] = *(const f32x4*)(rope + (size_t)4096 * 32 + (size_t)pos * 32 + (cl >> 1)); }
            asm volatile("" ::: "memory");
#pragma unroll
            for (int ai = 0; ai < 2; ++ai)
#pragma unroll
                for (int m = 0; m < 4; ++m) {
                    const int r = row0 + ai * 128 + m;
                    f32x4 v0 = acc[ai][0][m][0], v1 = acc[ai][0][m][1];
                    if (seg != 0) {
                        const f32x4 cs = csv[ai * 4 + m];
                        const f32x4 sn = snv[ai * 4 + m];
                        f32x4 o0, o1;
                        o0[0] = v0[0] * cs[0] - v0[1] * sn[0]; o0[1] = v0[0] * sn[0] + v0[1] * cs[0];
                        o0[2] = v0[2] * cs[1] - v0[3] * sn[1]; o0[3] = v0[2] * sn[1] + v0[3] * cs[1];
                        o1[0] = v1[0] * cs[2] - v1[1] * sn[2]; o1[1] = v1[0] * sn[2] + v1[1] * cs[2];
                        o1[2] = v1[2] * cs[3] - v1[3] * sn[3]; o1[3] = v1[2] * sn[3] + v1[3] * cs[3];
                        v0 = o0; v1 = o1;
                    }
                    const u32x4 w = pack8(v0, v1);
                    bf16_t* rp = dst + (size_t)r * 1536 + 128 + cl;
#pragma unroll
                    for (int h = 0; h < 8; ++h) *(u32x4*)(rp + h * 192) = w;
                }
            return;
        }
        if (mode == 2) {
            unsigned char* SGB = ws + WS_SG;
#pragma unroll
            for (int ai = 0; ai < 2; ++ai)
#pragma unroll
                for (int m = 0; m < 4; ++m) {
                    unsigned char* rp = SGB + (size_t)(row0 + ai * 128 + m) * 6144 + cbase + wc * 32 + 8 * fq;
#pragma unroll
                    for (int bj = 0; bj < 2; ++bj) {
                        unsigned q[8];
#pragma unroll
                        for (int n = 0; n < 2; ++n) {
                            const f32x4 tt = acc[ai][bj][m][n] * (-1.4426950408889634f);
                            const f32x4 dd = (f32x4){__builtin_amdgcn_exp2f(tt[0]), __builtin_amdgcn_exp2f(tt[1]), __builtin_amdgcn_exp2f(tt[2]), __builtin_amdgcn_exp2f(tt[3])} + 1.f;
                            const f32x4 sg = (f32x4){__builtin_amdgcn_rcpf(dd[0]), __builtin_amdgcn_rcpf(dd[1]), __builtin_amdgcn_rcpf(dd[2]), __builtin_amdgcn_rcpf(dd[3])} * 256.f;
#pragma unroll
                            for (int j = 0; j < 4; ++j) q[4 * n + j] = (unsigned)fminf(sg[j], 255.f);
                        }
                        u32x2 w; w.x = q[0] | (q[1] << 8) | (q[2] << 16) | (q[3] << 24); w.y = q[4] | (q[5] << 8) | (q[6] << 16) | (q[7] << 24);
                        *(u32x2*)(rp + bj * 128) = w;
                    }
                }
            return;
        }
#pragma unroll
        for (int ai = 0; ai < 2; ++ai)
#pragma unroll
            for (int m = 0; m < 4; ++m) {
                bf16_t* rp = dst + (size_t)(row0 + ai * 128 + m) * ld + cbase + wc * 32 + 8 * fq;
#pragma unroll
                for (int bj = 0; bj < 2; ++bj) {
                    f32x4 v0 = acc[ai][bj][m][0], v1 = acc[ai][bj][m][1];
                    if (mode == 1) {
#define GELU4(v) do { const f32x4 _t = (v) * ((v) * (v) * (0.044715f * 2.f * 0.7978845608028654f * -1.4426950408889634f) + (2.f * 0.7978845608028654f * -1.4426950408889634f)); \
                        const f32x4 _d = (f32x4){__builtin_amdgcn_exp2f(_t[0]), __builtin_amdgcn_exp2f(_t[1]), __builtin_amdgcn_exp2f(_t[2]), __builtin_amdgcn_exp2f(_t[3])} + 1.f; \
                        (v) = (v) * (f32x4){__builtin_amdgcn_rcpf(_d[0]), __builtin_amdgcn_rcpf(_d[1]), __builtin_amdgcn_rcpf(_d[2]), __builtin_amdgcn_rcpf(_d[3])}; } while (0)
                        GELU4(v0); GELU4(v1);
#undef GELU4
                    }
                    *(u32x4*)(rp + bj * 128) = pack8(v0, v1);
                }
            }
    }
};

template <int CTRL> __device__ __forceinline__ float dpp_get(float v) { return __int_as_float(__builtin_amdgcn_update_dpp(__float_as_int(v), __float_as_int(v), CTRL, 0xf, 0xf, false)); }
struct EpiGates {
    static constexpr bool PERM = false; static constexpr int KHOOK = 0; static constexpr bool APERM = true;
    unsigned char* ws; const float *b_a, *b_x, *sp8;
    __device__ __forceinline__ void operator()(const AccT& acc, const pg8::Unit& u) const {
        EPI_LANES();
        const int d = u.pn >> 3, blk = u.pn & 7;
        unsigned* AB = (unsigned*)(ws + WS_AB) + (size_t)d * TT * 1024;
        const bf16_t* U = (const bf16_t*)(ws + WS_U);
        float* Pp = (float*)(ws + WS_PS); float* Sp = Pp + (size_t)NB * 2 * 68 * 1024;
        const int bb = u.pm / PAN, seg = u.pm % PAN;
        f32x4 ba[2], bx[2], spm[2];
#pragma unroll
        for (int n = 0; n < 2; ++n) { const int c = blk * 128 + wc * 32 + 16 * n + 4 * fq;
            ba[n] = *(const f32x4*)(b_a + d * 1024 + c); bx[n] = *(const f32x4*)(b_x + d * 1024 + c); spm[n] = *(const f32x4*)(sp8 + d * 1024 + c) * (-2.f / 65535.f); }
        u32x2 uwa[2][2][4];
#pragma unroll
        for (int ai = 0; ai < 2; ++ai)
#pragma unroll
            for (int n = 0; n < 2; ++n)
#pragma unroll
                for (int m = 0; m < 4; ++m) uwa[ai][n][m] = *(const u32x2*)(U + ((size_t)u.pm * 256 + ai * 128 + wr * 64 + 4 * fr + m) * 1024 + blk * 128 + wc * 32 + 16 * n + 4 * fq);
        asm volatile("" ::: "memory");
#pragma unroll
        for (int ai = 0; ai < 2; ++ai) {
            const size_t tok0 = (size_t)u.pm * 256 + ai * 128 + wr * 64 + 4 * fr;
#pragma unroll
            for (int n = 0; n < 2; ++n) { const int c = blk * 128 + wc * 32 + 16 * n + 4 * fq;
                f32x4 Pt, St;
#pragma unroll
                for (int j = 0; j < 4; ++j) { Pt[j] = 1.f; St[j] = 0.f; }
                float av[4][4], bv[4][4];
#pragma unroll
                for (int m = 0; m < 4; ++m) {
                    const u32x2 uw = uwa[ai][n][m];
                    const float uu[4] = {bflo(uw.x), bfhi(uw.x), bflo(uw.y), bfhi(uw.y)};
                    u32x4 ow;
#pragma unroll
                    for (int jp = 0; jp < 2; ++jp) {
                        const int j0 = 2 * jp, j1 = 2 * jp + 1;
                        const f32x2 ga = (f32x2){acc[ai][0][m][n][j0] + ba[n][j0], acc[ai][0][m][n][j1] + ba[n][j1]};
                        const f32x2 gx = (f32x2){acc[ai][1][m][n][j0] + bx[n][j0], acc[ai][1][m][n][j1] + bx[n][j1]};
                        const f32x2 ta = ga * (-1.4426950408889634f), tx = gx * (-1.4426950408889634f);
                        const f32x2 da = (f32x2){__builtin_amdgcn_exp2f(ta.x), __builtin_amdgcn_exp2f(ta.y)} + 1.f, dx = (f32x2){__builtin_amdgcn_exp2f(tx.x), __builtin_amdgcn_exp2f(tx.y)} + 1.f;
                        const f32x2 rg = (f32x2){__builtin_amdgcn_rcpf(da.x), __builtin_amdgcn_rcpf(da.y)}, ig = (f32x2){__builtin_amdgcn_rcpf(dx.x), __builtin_amdgcn_rcpf(dx.y)};
                        const f32x2 rs = rg * 65535.f + 0.5f;
                        const unsigned rq0 = (unsigned)rs.x, rq1 = (unsigned)rs.y;
                        const f32x2 x2 = (f32x2){(float)rq0, (float)rq1} * (f32x2){spm[n][j0], spm[n][j1]};
                        const f32x2 ea = x2 * (0.5f * 1.4426950408889634f);
                        const f32x2 aa = (f32x2){__builtin_amdgcn_exp2f(ea.x), __builtin_amdgcn_exp2f(ea.y)};
                        f32x2 q = x2 * 0.25f + 1.f; q = q * (x2 * (1.f / 3.f)) + 1.f; q = q * (x2 * 0.5f) + 1.f;
                        const f32x2 ser = -x2 * q, dir = 1.f - aa * aa;
                        const f32x2 om = (f32x2){x2.x > -0.25f ? ser.x : dir.x, x2.y > -0.25f ? ser.y : dir.y};
                        const f32x2 iu = ig * (f32x2){uu[j0], uu[j1]};
                        const f32x2 bbv = (f32x2){__builtin_amdgcn_sqrtf(om.x), __builtin_amdgcn_sqrtf(om.y)} * iu;
                        const unsigned bw0 = cvt_pk_bf16(bbv.x, 0.f) << 16, bw1 = cvt_pk_bf16(bbv.y, 0.f) << 16;
                        ow[j0] = rq0 | bw0; ow[j1] = rq1 | bw1;
                        av[m][j0] = aa.x; av[m][j1] = aa.y; bv[m][j0] = __uint_as_float(bw0); bv[m][j1] = __uint_as_float(bw1);
                    }
                    *(u32x4*)(AB + (tok0 + m) * 1024 + c) = ow;
                }
#pragma unroll
                for (int mm = 0; mm < 4; ++mm) { const int m = d ? 3 - mm : mm;
#pragma unroll
                    for (int j = 0; j < 4; ++j) { St[j] = av[m][j] * St[j] + bv[m][j]; Pt[j] *= av[m][j]; } }
#pragma unroll
                for (int j = 0; j < 4; ++j) {
                    float P = Pt[j], S = St[j];
                    if (d == 0) {
                        { const float pe = dpp_get<0x111>(P), se = dpp_get<0x111>(S); S = P * se + S; P = P * pe; }
                        { const float pe = dpp_get<0x112>(P), se = dpp_get<0x112>(S); S = P * se + S; P = P * pe; }
                        { const float pe = dpp_get<0x114>(P), se = dpp_get<0x114>(S); S = P * se + S; P = P * pe; }
                        { const float pe = dpp_get<0x118>(P), se = dpp_get<0x118>(S); S = P * se + S; P = P * pe; }
                    } else {
                        { const float pe = dpp_get<0x101>(P), se = dpp_get<0x101>(S); S = P * se + S; P = P * pe; }
                        { const float pe = dpp_get<0x102>(P), se = dpp_get<0x102>(S); S = P * se + S; P = P * pe; }
                        { const float pe = dpp_get<0x104>(P), se = dpp_get<0x104>(S); S = P * se + S; P = P * pe; }
                        { const float pe = dpp_get<0x108>(P), se = dpp_get<0x108>(S); S = P * se + S; P = P * pe; }
                    }
                    Pt[j] = P; St[j] = S;
                }
                if (fr == (d ? 0 : 15)) { const size_t o = ((size_t)(bb * 2 + d) * 68 + seg * 4 + ai * 2 + wr) * 1024 + c; *(f32x4*)(Pp + o) = Pt; *(f32x4*)(Sp + o) = St; }
            }
        }
    }
};

struct EpiQup {
    static constexpr bool PERM = true; static constexpr int KHOOK = 0;
    unsigned char* ws; const float* rope;
    __device__ __forceinline__ void operator()(const AccT& acc, const pg8::Unit& u) const {
        EPI_LANES();
        const float* rs = (const float*)(ws + WS_RSQ); bf16_t* Q = (bf16_t*)(ws + WS_QM);
        const int seg = u.pm % PAN; const int row0 = u.pm * 256 + wr * 64 + fr;
        float sv[8];
#pragma unroll
        for (int q = 0; q < 8; ++q) sv[q] = rs[row0 + (q >> 2) * 128 + (q & 3) * 16];
#pragma unroll
        for (int ai = 0; ai < 2; ++ai)
#pragma unroll
        for (int mh = 0; mh < 2; ++mh) {
            f32x4 csv[2][2], snv[2][2];
#pragma unroll
            for (int mm = 0; mm < 2; ++mm)
#pragma unroll
                for (int bj = 0; bj < 2; ++bj) { const int j = (u.pn * 256 + bj * 128 + wc * 32 + 8 * fq) % 192; const bool rp = (j >= 128 && seg != 0);
                    const int pos = rp ? (seg - 1) * 256 + (wr * 64 + fr + ai * 128 + (mh * 2 + mm) * 16) : 0; const int pj = rp ? (j - 128) >> 1 : 0;
                    csv[mm][bj] = *(const f32x4*)(rope + (size_t)pos * 32 + pj); snv[mm][bj] = *(const f32x4*)(rope + (size_t)4096 * 32 + (size_t)pos * 32 + pj); }
            asm volatile("" ::: "memory");
#pragma unroll
            for (int mm = 0; mm < 2; ++mm) { const int m = mh * 2 + mm;
                const int r = row0 + ai * 128 + m * 16; const float s = sv[ai * 4 + m];
#pragma unroll
                for (int bj = 0; bj < 2; ++bj) {
                    const int c0 = u.pn * 256 + bj * 128 + wc * 32 + 8 * fq; const int j = c0 % 192;
                    f32x4 v0 = acc[ai][bj][m][0] * s, v1 = acc[ai][bj][m][1] * s;
                    if (j >= 128 && seg != 0) {
                        const f32x4 cs = csv[mm][bj];
                        const f32x4 sn = snv[mm][bj];
                        f32x4 o0, o1;
                        o0[0] = v0[0] * cs[0] - v0[1] * sn[0]; o0[1] = v0[0] * sn[0] + v0[1] * cs[0];
                        o0[2] = v0[2] * cs[1] - v0[3] * sn[1]; o0[3] = v0[2] * sn[1] + v0[3] * cs[1];
                        o1[0] = v1[0] * cs[2] - v1[1] * sn[2]; o1[1] = v1[0] * sn[2] + v1[1] * cs[2];
                        o1[2] = v1[2] * cs[3] - v1[3] * sn[3]; o1[3] = v1[2] * sn[3] + v1[3] * cs[3];
                        v0 = o0; v1 = o1;
                    }
                    *(u32x4*)(Q + (size_t)r * 1536 + c0) = pack8(v0, v1);
                }
            }
        }
    }
};

struct EpiKVup {
    static constexpr bool PERM = true; static constexpr int KHOOK = 0;
    unsigned char* ws;
    __device__ __forceinline__ void operator()(const AccT& acc, const pg8::Unit& u) const {
        EPI_LANES();
        const float* rs = (const float*)(ws + WS_RSKV); bf16_t* Kd = (bf16_t*)(ws + WS_KM); bf16_t* Vd = (bf16_t*)(ws + WS_VM);
        const int row0 = u.pm * 256 + wr * 64 + fr; const int cl = wc * 32 + 8 * fq;
        float sv[8];
#pragma unroll
        for (int q = 0; q < 8; ++q) sv[q] = rs[row0 + (q >> 2) * 128 + (q & 3) * 16];
        asm volatile("" ::: "memory");
#pragma unroll
        for (int ai = 0; ai < 2; ++ai)
#pragma unroll
            for (int m = 0; m < 4; ++m) {
                const size_t r = (size_t)(row0 + ai * 128 + m * 16); const float s = sv[ai * 4 + m];
                *(u32x4*)(Kd + r * 1536 + u.pn * 192 + cl) = pack8(acc[ai][0][m][0] * s, acc[ai][0][m][1] * s);
                *(u32x4*)(Vd + r * 1024 + u.pn * 128 + cl) = pack8(acc[ai][1][m][0] * s, acc[ai][1][m][1] * s);
            }
    }
};

__device__ __forceinline__ float gate_u8(unsigned w, int k) { return ((float)((w >> (8 * k)) & 0xffu) + 0.5f) * (1.f / 256.f); }
__device__ __forceinline__ f32x4 gate_u8x4(unsigned w) { return (f32x4){(float)(w & 0xffu), (float)((w >> 8) & 0xffu), (float)((w >> 16) & 0xffu), (float)(w >> 24)} * (1.f / 256.f) + (0.5f / 256.f); }
struct EpiMergeF {
    static constexpr bool PERM = true; static constexpr int KHOOK = 16;
    unsigned char* ws;
    __device__ __forceinline__ void khook(AccT& acc, const pg8::Unit& u, int i) const {
        EPI_LANES();
        const unsigned char* SG = ws + WS_SG + (i - 1) * 2048;
        const int row0 = u.pm * 256 + wr * 64 + fr;
#pragma unroll
        for (int ai = 0; ai < 2; ++ai) {
            u32x2 gpv[4][2], gnv[4][2];
#pragma unroll
            for (int m = 0; m < 4; ++m)
#pragma unroll
                for (int bj = 0; bj < 2; ++bj) { const size_t o = (size_t)(row0 + ai * 128 + m * 16) * 6144 + u.pn * 256 + bj * 128 + wc * 32 + 8 * fq;
                    gpv[m][bj] = *(const u32x2*)(SG + o); gnv[m][bj] = *(const u32x2*)(SG + o + 2048); }
            asm volatile("" ::: "memory");
#pragma unroll
            for (int m = 0; m < 4; ++m) {
#pragma unroll
                for (int bj = 0; bj < 2; ++bj) {
                    const u32x2 gp = gpv[m][bj], gn = gnv[m][bj];
#pragma unroll
                    for (int n = 0; n < 2; ++n) { const f32x4 nu = gate_u8x4(n ? gp.y : gp.x), de = gate_u8x4(n ? gn.y : gn.x);
                        acc[ai][bj][m][n] *= nu * (f32x4){__builtin_amdgcn_rcpf(de[0]), __builtin_amdgcn_rcpf(de[1]), __builtin_amdgcn_rcpf(de[2]), __builtin_amdgcn_rcpf(de[3])}; }
                }
            }
        }
    }
    __device__ __forceinline__ void operator()(const AccT& acc, const pg8::Unit& u) const {
        EPI_LANES();
        const unsigned char* SG = ws + WS_SG + 2 * 2048; bf16_t* YB = (bf16_t*)(ws + WS_YMB);
        const int row0 = u.pm * 256 + wr * 64 + fr;
        u32x2 gwv[2][4][2];
#pragma unroll
        for (int ai = 0; ai < 2; ++ai)
#pragma unroll
            for (int m = 0; m < 4; ++m)
#pragma unroll
                for (int bj = 0; bj < 2; ++bj) gwv[ai][m][bj] = *(const u32x2*)(SG + (size_t)(row0 + ai * 128 + m * 16) * 6144 + u.pn * 256 + bj * 128 + wc * 32 + 8 * fq);
        asm volatile("" ::: "memory");
#pragma unroll
        for (int ai = 0; ai < 2; ++ai)
#pragma unroll
            for (int m = 0; m < 4; ++m) {
                const size_t r = (size_t)(row0 + ai * 128 + m * 16);
#pragma unroll
                for (int bj = 0; bj < 2; ++bj) {
                    const int c0 = u.pn * 256 + bj * 128 + wc * 32 + 8 * fq;
                    const u32x2 gw = gwv[ai][m][bj];
                    const f32x4 g0 = gate_u8x4(gw.x), g1 = gate_u8x4(gw.y);
                    *(u32x4*)(YB + r * 2048 + c0) = pack8(acc[ai][bj][m][0] * g0, acc[ai][bj][m][1] * g1);
                }
            }
    }
};

struct EpiResid {
    static constexpr bool PERM = true; static constexpr int KHOOK = 0;
    unsigned char* ws; int goff;
    const float* gain; int scoff, nidx;
    __device__ __forceinline__ void operator()(const AccT& acc, const pg8::Unit& u) const {
        EPI_LANES();
        const int rl0 = wr * 64 + fr;
        if (u.split) {
            unsigned short* PT = (unsigned short*)(ws + WS_PART) + ((size_t)((u.pm / PAN) * 8 + u.pn) * KSPLIT + (u.split - 1)) * 65536;
#pragma unroll
            for (int ai = 0; ai < 2; ++ai)
#pragma unroll
                for (int m = 0; m < 4; ++m)
#pragma unroll
                    for (int bj = 0; bj < 2; ++bj) { const f32x4 v0 = acc[ai][bj][m][0], v1 = acc[ai][bj][m][1];
                        u32x4 w; w.x = pack_h2(v0[0], v0[1]); w.y = pack_h2(v0[2], v0[3]); w.z = pack_h2(v1[0], v1[1]); w.w = pack_h2(v1[2], v1[3]);
                        *(u32x4*)(PT + (size_t)(rl0 + ai * 128 + m * 16) * 256 + bj * 128 + wc * 32 + 8 * fq) = w; }
            return;
        }
        const int b = u.pm / PAN, seg = u.pm % PAN, mr = seg == 0 ? 4 : b;
        const float* gp = (const float*)(ws + WS_MOD) + goff + mr * 12288;
        unsigned short* XSp = (unsigned short*)(ws + WS_XS) + (size_t)u.pm * 256 * 2048; bf16_t* XG = (bf16_t*)(ws + WS_H) + (size_t)u.pm * 256 * 2048;
        f32x4 gv[2][2], Gv[2][2];
        const float* gainq = gain ? gain : gp; const float* scq = (const float*)(ws + WS_MOD) + (gain ? scoff : goff) + mr * 12288;
#pragma unroll
        for (int bj = 0; bj < 2; ++bj)
#pragma unroll
            for (int n = 0; n < 2; ++n) { const int c = u.pn * 256 + bj * 128 + wc * 32 + 8 * fq + 4 * n; gv[bj][n] = *(const f32x4*)(gp + c);
                Gv[bj][n] = *(const f32x4*)(gainq + c) * (*(const f32x4*)(scq + c) + 1.f); }
        float rsum[8];
        u32x4 xa[2][2], xb[2][2];
#define RQ_ROW(q, mm) ((size_t)(rl0 + ((q) >> 1) * 128 + (((q) & 1) * 2 + (mm)) * 16) * 2048 + u.pn * 256 + wc * 32 + 8 * fq)
#define RQ_LD(buf, q) do { _Pragma("unroll") for (int mm = 0; mm < 2; ++mm) _Pragma("unroll") for (int bj = 0; bj < 2; ++bj) buf[mm][bj] = *(const u32x4*)(XSp + RQ_ROW(q, mm) + bj * 128); asm volatile("" ::: "memory"); } while (0)
#define RQ_DO(buf, q) do { _Pragma("unroll") for (int mm = 0; mm < 2; ++mm) { const int ai = (q) >> 1, m = ((q) & 1) * 2 + mm; const size_t ro = RQ_ROW(q, mm); float ss = 0.f; \
            _Pragma("unroll") for (int bj = 0; bj < 2; ++bj) { const u32x4 xo = buf[mm][bj]; \
                const f32x4 x0 = (f32x4){h2lo(xo.x), h2hi(xo.x), h2lo(xo.y), h2hi(xo.y)} + gv[bj][0] * acc[ai][bj][m][0], x1 = (f32x4){h2lo(xo.z), h2hi(xo.z), h2lo(xo.w), h2hi(xo.w)} + gv[bj][1] * acc[ai][bj][m][1]; \
                u32x4 w; w.x = pack_h2(x0[0], x0[1]); w.y = pack_h2(x0[2], x0[3]); w.z = pack_h2(x1[0], x1[1]); w.w = pack_h2(x1[2], x1[3]); \
                *(u32x4*)(XSp + ro + bj * 128) = w; \
                if (gain) { const f32x4 y0 = x0 * Gv[bj][0], y1 = x1 * Gv[bj][1]; \
                    u32x4 yw; yw.x = cvt_pk_bf16(y0[0], y0[1]); yw.y = cvt_pk_bf16(y0[2], y0[3]); yw.z = cvt_pk_bf16(y1[0], y1[1]); yw.w = cvt_pk_bf16(y1[2], y1[3]); \
                    *(u32x4*)(XG + ro + bj * 128) = yw; \
                    const f32x4 q_ = x0 * x0 + x1 * x1; ss += (q_[0] + q_[1]) + (q_[2] + q_[3]); } } \
            rsum[ai * 4 + m] = ss; } asm volatile("" ::: "memory"); } while (0)
        RQ_LD(xa, 0); RQ_LD(xb, 1); RQ_DO(xa, 0); RQ_LD(xa, 2); RQ_DO(xb, 1); RQ_LD(xb, 3); RQ_DO(xa, 2); RQ_DO(xb, 3);
#undef RQ_ROW
#undef RQ_LD
#undef RQ_DO
        if (gain) {
#pragma unroll
            for (int j = 0; j < 8; ++j) { float v = rsum[j]; v += __shfl_xor(v, 16); v += __shfl_xor(v, 32); rsum[j] = v; }
            unsigned long long* SQ = (unsigned long long*)(ws + WS_SSQ) + (size_t)nidx * TT + (size_t)u.pm * 256 + rl0;
#pragma unroll
            for (int h = 0; h < 2; ++h) {
                const float v = fq == 0 ? rsum[h * 4] : fq == 1 ? rsum[h * 4 + 1] : fq == 2 ? rsum[h * 4 + 2] : rsum[h * 4 + 3];
                atomicAdd(SQ + h * 128 + fq * 16, __float2ull_rn(v * 16777216.f));
            }
        }
    }
};

__device__ __forceinline__ float dpp_ror1(float src) { return __int_as_float(__builtin_amdgcn_update_dpp(0, __float_as_int(src), 0x121, 0xf, 0xf, false)); }
__device__ __forceinline__ float dpp_ror15(float src) { return __int_as_float(__builtin_amdgcn_update_dpp(0, __float_as_int(src), 0x12F, 0xf, 0xf, false)); }
struct EpiFfnUp {
    static constexpr bool PERM = true; static constexpr int KHOOK = 0; static constexpr bool APERM = true; static constexpr bool PREF = true; static constexpr bool CTXWAIT = true;
    __device__ __forceinline__ void ctx_wait() const { rsc.ctx_wait(); }
    unsigned char* ws; const float* cw; const float* cb; char* lds; RowScale rsc;
    __device__ __forceinline__ void prefetch(LAS unsigned char* l, const pg8::Unit& u, int wid, int lane) const { rsc.prefetch(l, u, wid, lane);
        const int t = wid & 3; const float* src = (t < 3 ? cw + (size_t)t * DFF2 : cb) + (wid >> 2) * DFF + u.pn * 128 + lane;
        LAS unsigned char* d = l + LDS_CW + u.par * 4096 + wid * 512;
        __builtin_amdgcn_global_load_lds((const unsigned*)src, (LAS unsigned*)d, 4, 0, 0); __builtin_amdgcn_global_load_lds((const unsigned*)(src + 64), (LAS unsigned*)(d + 256), 4, 0, 0); }
    __device__ __forceinline__ void operator()(AccT& acc, const pg8::Unit& u) const {
        EPI_LANES();
        rsc.apply(acc, u, lds, wr, wc, fr, fq);
        float* EX = (float*)(lds + LDS_EXCH);
        const int jb = u.pn * 128 + wc * 32 + 8 * fq;
        if (fr == 0 || fr == 15) {
            const int m = fr == 0 ? 0 : 3, which = fr == 0 ? 0 : 1;
#pragma unroll
            for (int ai = 0; ai < 2; ++ai)
#pragma unroll
                for (int bj = 0; bj < 2; ++bj)
#pragma unroll
                    for (int n = 0; n < 2; ++n) *(f32x4*)(EX + (((ai * 2 + wr) * 2 + which) * 4 + wc) * 64 + ((bj * 4 + fq) * 2 + n) * 4) = acc[ai][bj][m][n];
        }
        {
            float* HL = (float*)(ws + WS_HALO) + (size_t)u.pm * 4 * DFF2;
            if (wr == 0 && fr == 0) {
#pragma unroll
                for (int m = 0; m < 2; ++m)
#pragma unroll
                    for (int n = 0; n < 2; ++n) { *(f32x4*)(HL + (size_t)m * DFF2 + jb + 4 * n) = acc[0][0][m][n]; *(f32x4*)(HL + (size_t)m * DFF2 + DFF + jb + 4 * n) = acc[0][1][m][n]; }
            }
            if (wr == 1 && fr == 15) {
#pragma unroll
                for (int m = 2; m < 4; ++m)
#pragma unroll
                    for (int n = 0; n < 2; ++n) { *(f32x4*)(HL + (size_t)m * DFF2 + jb + 4 * n) = acc[1][0][m][n]; *(f32x4*)(HL + (size_t)m * DFF2 + DFF + jb + 4 * n) = acc[1][1][m][n]; }
            }
        }
        asm volatile("s_waitcnt lgkmcnt(0)" ::: "memory");
        __builtin_amdgcn_s_barrier();
        __builtin_amdgcn_s_barrier();
        asm volatile("" ::: "memory");
        bf16_t* ACT = (bf16_t*)(ws + WS_ACT);
        const int row0 = u.pm * 256 + wr * 64 + 4 * fr;
#pragma unroll
        for (int ai = 0; ai < 2; ++ai) {
            const int blk = ai * 2 + wr;
            u32x2 outw[4][2];
#pragma unroll
            for (int n = 0; n < 2; ++n) {
                f32x4 w0v, w1v, w2v, bv, w0g, w1g, w2g, bg;
                { const float* cl = (const float*)(lds + LDS_CW + u.par * 4096) + wc * 32 + 8 * fq + 4 * n;
                  w0v = *(const f32x4*)(cl); w1v = *(const f32x4*)(cl + 128); w2v = *(const f32x4*)(cl + 256); bv = *(const f32x4*)(cl + 384);
                  w0g = *(const f32x4*)(cl + 512); w1g = *(const f32x4*)(cl + 640); w2g = *(const f32x4*)(cl + 768); bg = *(const f32x4*)(cl + 896); }
                f32x4 tv = {0.f, 0.f, 0.f, 0.f}, tg = tv, bvh = tv, bgh = tv;
                if (blk > 0) { const float* e = EX + ((((blk - 1) * 2 + 1) * 4 + wc) * 64); tv = *(const f32x4*)(e + ((0 * 4 + fq) * 2 + n) * 4); tg = *(const f32x4*)(e + ((1 * 4 + fq) * 2 + n) * 4); }
                if (blk < 3) { const float* e = EX + ((((blk + 1) * 2 + 0) * 4 + wc) * 64); bvh = *(const f32x4*)(e + ((0 * 4 + fq) * 2 + n) * 4); bgh = *(const f32x4*)(e + ((1 * 4 + fq) * 2 + n) * 4); }
                f32x4 pv0, pg0, nv3, ng3;
#pragma unroll
                for (int j = 0; j < 4; ++j) {
                    pv0[j] = dpp_shr1(tv[j], acc[ai][0][3][n][j]); pg0[j] = dpp_shr1(tg[j], acc[ai][1][3][n][j]);
                    nv3[j] = dpp_shl1(bvh[j], acc[ai][0][0][n][j]); ng3[j] = dpp_shl1(bgh[j], acc[ai][1][0][n][j]);
                }
#pragma unroll
                for (int m = 0; m < 4; ++m) {
                    const f32x4 pv4 = m == 0 ? pv0 : acc[ai][0][m - 1 < 0 ? 0 : m - 1][n], pg4 = m == 0 ? pg0 : acc[ai][1][m - 1 < 0 ? 0 : m - 1][n];
                    const f32x4 nv4 = m == 3 ? nv3 : acc[ai][0][m + 1 > 3 ? 3 : m + 1][n], ng4 = m == 3 ? ng3 : acc[ai][1][m + 1 > 3 ? 3 : m + 1][n];
                    const f32x4 uv = bv + w0v * pv4 + w1v * acc[ai][0][m][n] + w2v * nv4;
                    const f32x4 ug = bg + w0g * pg4 + w1g * acc[ai][1][m][n] + w2g * ng4;
                    const f32x4 tt = ug * (-1.4426950408889634f);
                    const f32x4 dd = (f32x4){__builtin_amdgcn_exp2f(tt[0]), __builtin_amdgcn_exp2f(tt[1]), __builtin_amdgcn_exp2f(tt[2]), __builtin_amdgcn_exp2f(tt[3])} + 1.f;
                    const f32x4 o = (ug * uv) * (f32x4){__builtin_amdgcn_rcpf(dd[0]), __builtin_amdgcn_rcpf(dd[1]), __builtin_amdgcn_rcpf(dd[2]), __builtin_amdgcn_rcpf(dd[3])};
                    outw[m][n].x = cvt_pk_bf16(o[0], o[1]); outw[m][n].y = cvt_pk_bf16(o[2], o[3]);
                }
            }
#pragma unroll
            for (int m = 0; m < 4; ++m) { u32x4 w; w.x = outw[m][0].x; w.y = outw[m][0].y; w.z = outw[m][1].x; w.w = outw[m][1].y;
                *(u32x4*)(ACT + (size_t)(row0 + ai * 128 + m) * DFF + jb) = w; }
        }
    }
};

struct EpiStoreBf16 {
    static constexpr bool PERM = true; static constexpr int KHOOK = 0;
    bf16_t* O; int ld;
    __device__ __forceinline__ void operator()(const AccT& acc, const pg8::Unit& u) const {
        EPI_LANES();
        const int row0 = u.pm * 256 + wr * 64 + fr;
#pragma unroll
        for (int ai = 0; ai < 2; ++ai)
#pragma unroll
            for (int m = 0; m < 4; ++m) {
                bf16_t* rp = O + (size_t)(row0 + ai * 128 + m * 16) * ld + u.pn * 256 + wc * 32 + 8 * fq;
#pragma unroll
                for (int bj = 0; bj < 2; ++bj) *(u32x4*)(rp + bj * 128) = pack8(acc[ai][bj][m][0], acc[ai][bj][m][1]);
            }
    }
};

#define SBAR() __builtin_amdgcn_sched_barrier(0)
__device__ __forceinline__ int crow(int r, int hi) { return (r & 3) + 8 * (r >> 2) + 4 * hi; }
constexpr float ATT_THR = 8.f;
template <int DQK> struct AttC { static constexpr float SCALE = (DQK == 128) ? 0.08838834764831845f : 0.07216878364870323f; static constexpr int KROWB = (DQK == 128) ? 256 : 512; };
__device__ __forceinline__ int kswz(int row) { return ((row & 7) | ((row >> 1) & 8)) << 4; }

template <int DQK>
__device__ __forceinline__ void partialSM(f32x16& p0, f32x16& p1, float& m_reg, float& mn, float& alpha) {
    constexpr float SCALE = AttC<DQK>::SCALE; constexpr float C = SCALE * 1.4426950408889634f;
    float pmax = p0[0];
#pragma unroll
    for (int r = 1; r < 16; ++r) pmax = fmaxf(pmax, p0[r]);
#pragma unroll
    for (int r = 0; r < 16; ++r) pmax = fmaxf(pmax, p1[r]);
    { auto rr = __builtin_amdgcn_permlane32_swap(__float_as_uint(pmax), __float_as_uint(pmax), false, false);
      pmax = fmaxf(__uint_as_float(rr[0]), __uint_as_float(rr[1])); }
    if (__builtin_expect(__all(pmax - m_reg <= ATT_THR / SCALE), 1)) { mn = m_reg; alpha = 1.f; }
    else { mn = fmaxf(m_reg, pmax); alpha = __builtin_amdgcn_exp2f((m_reg - mn) * C); m_reg = mn; }
    const float mnC = -mn * C;
#pragma unroll
    for (int r = 0; r < 16; ++r) p0[r] = fmaf(p0[r], C, mnC);
#pragma unroll
    for (int r = 0; r < 16; ++r) p1[r] = fmaf(p1[r], C, mnC);
#pragma unroll
    for (int r = 0; r < 16; ++r) p0[r] = __builtin_amdgcn_exp2f(p0[r]);
}
__device__ __forceinline__ void finishSM(f32x16& p0, f32x16& p1, float alpha, float& l_reg, bf16x8& pa0, bf16x8& pa1, bf16x8& pa2, bf16x8& pa3) {
#pragma unroll
    for (int r = 0; r < 16; ++r) p1[r] = __builtin_amdgcn_exp2f(p1[r]);
    float ps = 0;
#pragma unroll
    for (int r = 0; r < 16; ++r) ps += p0[r];
#pragma unroll
    for (int r = 0; r < 16; ++r) ps += p1[r];
    { auto rr = __builtin_amdgcn_permlane32_swap(__float_as_uint(ps), __float_as_uint(ps), false, false);
      ps = __uint_as_float(rr[0]) + __uint_as_float(rr[1]); }
    l_reg = l_reg * alpha + ps;
#define PK4(P, BASE, OUT) do { unsigned a0 = cvt_pk_bf16(P[BASE + 0], P[BASE + 1]), a1 = cvt_pk_bf16(P[BASE + 2], P[BASE + 3]);   \
    unsigned b0 = cvt_pk_bf16(P[BASE + 4], P[BASE + 5]), b1 = cvt_pk_bf16(P[BASE + 6], P[BASE + 7]);                              \
    auto r0 = __builtin_amdgcn_permlane32_swap(a0, b0, false, false); auto r1 = __builtin_amdgcn_permlane32_swap(a1, b1, false, false); \
    u32x4 w = {r0[0], r1[0], r0[1], r1[1]}; OUT = *reinterpret_cast<bf16x8*>(&w); } while (0)
    PK4(p0, 0, pa0); PK4(p0, 8, pa1); PK4(p1, 0, pa2); PK4(p1, 8, pa3);
#undef PK4
}
template <int DQK, int QL = 0>
__device__ __forceinline__ void qkt(f32x16& p0, f32x16& p1, const char* Ks, const bf16x8* qr, int r32, int hi, const char* Ql = nullptr) {
    constexpr int KROWB = AttC<DQK>::KROWB, ND = DQK / 16;
    p0 = f32x16{}; p1 = f32x16{};
#pragma unroll
    for (int d0 = 0; d0 < ND; ++d0) { const int cb = (d0 * 16 + hi * 8) * 2;
        const bf16x8 b0 = *reinterpret_cast<const bf16x8*>(Ks + r32 * KROWB + (cb ^ kswz(r32)));
        const bf16x8 b1 = *reinterpret_cast<const bf16x8*>(Ks + (32 + r32) * KROWB + (cb ^ kswz(r32)));
        bf16x8 qv;
        if (d0 < ND - QL) qv = qr[d0]; else qv = *reinterpret_cast<const bf16x8*>(Ql + ((((d0 - (ND - QL)) * 2 + hi) ^ ((r32 >> 1) & 7)) << 4));
        p0 = __builtin_amdgcn_mfma_f32_32x32x16_bf16(b0, qv, p0, 0, 0, 0);
        p1 = __builtin_amdgcn_mfma_f32_32x32x16_bf16(b1, qv, p1, 0, 0, 0); }
}
__device__ __forceinline__ int v_st(int k, int c) { const int kk = (k & ~0xC) | ((k & 4) << 1) | ((k & 8) >> 1); return ((kk >> 3) * 4 + (c >> 5)) * 512 + ((kk & 7) * 32 + (c & 31)) * 2; }
__device__ __forceinline__ int v_rd_base(int lane) { return ((lane & 3) << 3) | (((lane >> 2) & 3) << 6) | (((lane >> 4) & 1) << 5) | (((lane >> 5) & 1) << 8); }
constexpr int v_rd_off(int d0, int ks, int half) { return d0 * 512 + ks * 4096 + half * 2048; }
template <int OFF> __device__ __forceinline__ s16x4 tr_read(int vb) {
    s16x4 r; asm volatile("ds_read_b64_tr_b16 %0, %1 offset:%2" : "=&v"(r) : "v"(vb), "i"(OFF) : "memory"); return r;
}
template <int D0> __device__ __forceinline__ void pv_one(f32x16& od, int vb, bf16x8 pa0, bf16x8 pa1, bf16x8 pa2, bf16x8 pa3) {
    const s16x4 l0 = tr_read<v_rd_off(D0, 0, 0)>(vb), h0 = tr_read<v_rd_off(D0, 0, 1)>(vb), l1 = tr_read<v_rd_off(D0, 1, 0)>(vb), h1 = tr_read<v_rd_off(D0, 1, 1)>(vb);
    const s16x4 l2 = tr_read<v_rd_off(D0, 2, 0)>(vb), h2 = tr_read<v_rd_off(D0, 2, 1)>(vb), l3 = tr_read<v_rd_off(D0, 3, 0)>(vb), h3 = tr_read<v_rd_off(D0, 3, 1)>(vb);
    asm volatile("s_waitcnt lgkmcnt(0)" ::: "memory"); SBAR();
#define PKV(L, H) (bf16x8){L[0], L[1], L[2], L[3], H[0], H[1], H[2], H[3]}
    od = __builtin_amdgcn_mfma_f32_32x32x16_bf16(pa0, PKV(l0, h0), od, 0, 0, 0);
    od = __builtin_amdgcn_mfma_f32_32x32x16_bf16(pa1, PKV(l1, h1), od, 0, 0, 0);
    od = __builtin_amdgcn_mfma_f32_32x32x16_bf16(pa2, PKV(l2, h2), od, 0, 0, 0);
    od = __builtin_amdgcn_mfma_f32_32x32x16_bf16(pa3, PKV(l3, h3), od, 0, 0, 0);
#undef PKV
}
__device__ __forceinline__ void pv_d0(f32x16* o, int vb, bf16x8 pa0, bf16x8 pa1, bf16x8 pa2, bf16x8 pa3) {
    pv_one<0>(o[0], vb, pa0, pa1, pa2, pa3); pv_one<1>(o[1], vb, pa0, pa1, pa2, pa3); pv_one<2>(o[2], vb, pa0, pa1, pa2, pa3); pv_one<3>(o[3], vb, pa0, pa1, pa2, pa3);
}

template <int DQK>
__device__ __forceinline__ void qkt_p(f32x16& p0, f32x16& p1, const char* Ks, const bf16x8* qr, int r32, int hi) {
    constexpr int KROWB = AttC<DQK>::KROWB, ND = DQK / 16;
    const char* k0 = Ks + r32 * KROWB; const char* k1 = Ks + (32 + r32) * KROWB; const int sw = kswz(r32), hb = hi * 16;
    bf16x8 fa[3], fb[3];
#define QK_RD(d0, s) do { fa[s] = *reinterpret_cast<const bf16x8*>(k0 + (((d0) * 32 + hb) ^ sw)); fb[s] = *reinterpret_cast<const bf16x8*>(k1 + (((d0) * 32 + hb) ^ sw)); } while (0)
    QK_RD(0, 0); QK_RD(1, 1); SBAR();
    p0 = f32x16{}; p1 = f32x16{};
#pragma unroll
    for (int d0 = 0; d0 < ND; ++d0) {
        if (d0 + 2 < ND) QK_RD(d0 + 2, (d0 + 2) % 3);
        p0 = __builtin_amdgcn_mfma_f32_32x32x16_bf16(fa[d0 % 3], qr[d0], p0, 0, 0, 0);
        p1 = __builtin_amdgcn_mfma_f32_32x32x16_bf16(fb[d0 % 3], qr[d0], p1, 0, 0, 0);
        SBAR();
    }
#undef QK_RD
}
template <int KS> __device__ __forceinline__ void pv_ld(s16x4 (&l)[4], s16x4 (&h)[4], int vb) {
    l[0] = tr_read<v_rd_off(0, KS, 0)>(vb); h[0] = tr_read<v_rd_off(0, KS, 1)>(vb); l[1] = tr_read<v_rd_off(1, KS, 0)>(vb); h[1] = tr_read<v_rd_off(1, KS, 1)>(vb);
    l[2] = tr_read<v_rd_off(2, KS, 0)>(vb); h[2] = tr_read<v_rd_off(2, KS, 1)>(vb); l[3] = tr_read<v_rd_off(3, KS, 0)>(vb); h[3] = tr_read<v_rd_off(3, KS, 1)>(vb);
}
__device__ __forceinline__ void pv_mm(f32x16* o, bf16x8 pa, const s16x4 (&l)[4], const s16x4 (&h)[4]) {
#define PKV(L, H) (bf16x8){L[0], L[1], L[2], L[3], H[0], H[1], H[2], H[3]}
#pragma unroll
    for (int d = 0; d < 4; ++d) o[d] = __builtin_amdgcn_mfma_f32_32x32x16_bf16(pa, PKV(l[d], h[d]), o[d], 0, 0, 0);
#undef PKV
}
__device__ __forceinline__ void pv_il(f32x16* o, int vb, bf16x8 pa0, bf16x8 pa1, bf16x8 pa2, bf16x8 pa3) {
    s16x4 la[4], ha[4], lb[4], hb[4];
    pv_ld<0>(la, ha, vb);
    asm volatile("s_waitcnt lgkmcnt(0)" ::: "memory"); SBAR();
    pv_ld<1>(lb, hb, vb); pv_mm(o, pa0, la, ha);
    asm volatile("s_waitcnt lgkmcnt(0)" ::: "memory"); SBAR();
    pv_ld<2>(la, ha, vb); pv_mm(o, pa1, lb, hb);
    asm volatile("s_waitcnt lgkmcnt(0)" ::: "memory"); SBAR();
    pv_ld<3>(lb, hb, vb); pv_mm(o, pa2, la, ha);
    asm volatile("s_waitcnt lgkmcnt(0)" ::: "memory"); SBAR();
    pv_mm(o, pa3, lb, hb); SBAR();
}

struct AttnArgs {
    const bf16_t* Q; int ldq; const bf16_t* K; int ldk; const bf16_t* V; int ldv; bf16_t* O; int ldo;
    int ntiles; int kbase;
    int ctxbase, latbase, kstart;
    int rg;
};
template <int MODE> __device__ __forceinline__ int tile_row(const AttnArgs& a, int j) {
    if (MODE == 0) return a.kbase + 64 * j;
    return j < 4 ? a.ctxbase + 64 * j : a.latbase + 64 * (a.kstart + j - 4);
}
__device__ __forceinline__ void na_mod(f32x16& p0, f32x16& p1, int j, int kstart, int rq, int cq, const float* tab, int hi) {
    if (j < 4) return;
    const int kr = kstart + j - 4; const int krs = min(max(rq - 4, 0), 56); const int cs = min(max(cq - 8, 0), 48);
    const bool rowok = (unsigned)(kr - krs) < 8u;
    const int tb = (kr - rq + 7) * 31 + 15 - cq;
#pragma unroll
    for (int r = 0; r < 16; ++r) {
        const int kc = crow(r, hi);
        const bool ok0 = rowok && ((unsigned)(kc - cs) < 16u), ok1 = rowok && ((unsigned)(kc + 32 - cs) < 16u);
        const float b0 = tab[ok0 ? tb + kc : 0], b1 = tab[ok1 ? tb + kc + 32 : 0];
        p0[r] = ok0 ? p0[r] + b0 : -1e30f; p1[r] = ok1 ? p1[r] + b1 : -1e30f;
    }
}

constexpr int NA_TABP = 576;
__device__ __forceinline__ void na_mod2(f32x16& p0, f32x16& p1, const float* t, unsigned okm) {
    asm volatile("" : "+v"(okm));
#pragma unroll
    for (int r = 0; r < 16; ++r) {
        const int kc0 = (r & 3) + 8 * (r >> 2);
        const float x0 = p0[r] + t[kc0], x1 = p1[r] + t[kc0 + 32];
        const unsigned m0 = (unsigned)__builtin_amdgcn_sbfe((int)okm, r, 1), m1 = (unsigned)__builtin_amdgcn_sbfe((int)okm, 16 + r, 1);
        p0[r] = __uint_as_float((__float_as_uint(x0) & m0) | (0xf149f2cau & ~m0)); p1[r] = __uint_as_float((__float_as_uint(x1) & m1) | (0xf149f2cau & ~m1));
    }
}

template <int DQK, int MODE, int SDEPTH, int LDQ, int LDK, int LDV, int LDO, int QL = 0>
__device__ __forceinline__ void attn_body(const AttnArgs& a, char* lds, const float* tab) {
    constexpr int KCH = DQK / 64, KROWB = AttC<DQK>::KROWB, SHM_K = 64 * KROWB, SHM_V = 64 * 128 * 2, ND = DQK / 16, KC8 = DQK / 8;
    int tid = threadIdx.x; asm volatile("" : "+v"(tid));
    const int wid = __builtin_amdgcn_readfirstlane(tid >> 6), lane = tid & 63, r32 = lane & 31, hi = lane >> 5;
    char* V_lds = lds; char* K_lds = lds + 2 * SHM_V;
    float* wsf = (float*)(lds + 2 * SHM_V + 2 * SHM_K) + wid * 64; float* li_l = wsf; float* al_l = wsf + 32;
    float m_reg = -1e30f, l_reg = 0; f32x16 o[4] = {}; bf16x8 qr[ND - QL];
    { const char* Qw = (const char*)a.Q + (size_t)(wid * 32) * LDQ * 2; const unsigned qo = (unsigned)(r32 * LDQ + hi * 8) * 2u;
#pragma unroll
      for (int d0 = 0; d0 < ND - QL; ++d0) qr[d0] = *reinterpret_cast<const bf16x8*>(Qw + qo + d0 * 32); }
    char* Q_lds = lds + 2 * SHM_V + 2 * SHM_K + 2048;
    const char* Ql = Q_lds + (wid * 32 + r32) * (QL * 32);
    if (QL > 0) {
        static_assert(QL == 0 || QL == 4, "Q tail image is written for 128-byte rows");
#pragma unroll
        for (int i = 0; i < (256 * QL * 2) / 512; ++i) { const int cid = tid + 512 * i; const int row = cid / (QL * 2), ch = cid % (QL * 2);
            *(bf16x8*)(Q_lds + row * (QL * 32) + ((ch ^ ((row >> 1) & 7)) << 4)) = *reinterpret_cast<const bf16x8*>((const char*)a.Q + ((size_t)row * LDQ + (ND - QL) * 16 + ch * 8) * 2); }
    }
    const int rq = a.rg * 4 + (wid >> 1), cq = (wid & 1) * 32 + r32;
    const int sr = tid >> 4, sc = (tid & 15) * 8, vst0 = v_st(sr, sc), vst1 = v_st(32 + sr, sc);
    const unsigned voff = (unsigned)(sr * LDV + sc) * 2u;
    unsigned koff[KCH]; int kdst[KCH];
#pragma unroll
    for (int i = 0; i < KCH; ++i) { const int cid = tid + 512 * i; const int kr_ = cid / KC8, kc_ = (cid % KC8) * 8; koff[i] = (unsigned)(kr_ * LDK + kc_) * 2u; kdst[i] = kr_ * KROWB + ((kc_ * 2) ^ kswz(kr_)); }
    const int vb0 = (int)(uintptr_t)V_lds + v_rd_base(lane);
    struct { bf16x8 vs0, vs1; bf16x8 ks[KCH]; } sr_[SDEPTH];
#define SLOAD(i, j) do { const int _t0 = tile_row<MODE>(a, (j)); const char* _vb = (const char*)a.V + (size_t)_t0 * (LDV * 2); const char* _kb = (const char*)a.K + (size_t)_t0 * (LDK * 2); \
    sr_[i].vs0 = *reinterpret_cast<const bf16x8*>(_vb + voff); sr_[i].vs1 = *reinterpret_cast<const bf16x8*>(_vb + voff + 32 * LDV * 2); \
    _Pragma("unroll") for (int _k = 0; _k < KCH; ++_k) sr_[i].ks[_k] = *reinterpret_cast<const bf16x8*>(_kb + koff[_k]); } while (0)
#define SWRITE(b, i) do { *(bf16x8*)(V_lds + (b) * SHM_V + vst0) = sr_[i].vs0; *(bf16x8*)(V_lds + (b) * SHM_V + vst1) = sr_[i].vs1; \
    _Pragma("unroll") for (int _k = 0; _k < KCH; ++_k) *(bf16x8*)(K_lds + (b) * SHM_K + kdst[_k]) = sr_[i].ks[_k]; } while (0)
#define SWAIT() do { if constexpr (SDEPTH == 2) { if constexpr (KCH == 2) asm volatile("s_waitcnt vmcnt(4)" ::: "memory"); else asm volatile("s_waitcnt vmcnt(5)" ::: "memory"); } else asm volatile("s_waitcnt vmcnt(0)" ::: "memory"); } while (0)
#define RESC(al) do { if (__any((al) < 1.f)) { if (hi == 0) al_l[r32] = (al); asm volatile("s_waitcnt lgkmcnt(0)" ::: "memory"); \
    _Pragma("unroll") for (int d = 0; d < 4; ++d) _Pragma("unroll") for (int r = 0; r < 16; ++r) o[d][r] *= al_l[crow(r, hi)]; } } while (0)
#define AMOD(P0, P1, j) do { if (MODE == 1) na_mod(P0, P1, (j), a.kstart, rq, cq, tab, hi); } while (0)
    f32x16 pA0, pA1, pB0, pB1; float mnA, mnB, alA, alB; bf16x8 pa0, pa1, pa2, pa3; const int NT = a.ntiles;
    constexpr int SE = 0, SO = SDEPTH - 1;
    SLOAD(SE, 0); asm volatile("s_waitcnt vmcnt(0)" ::: "memory"); SWRITE(0, SE); __syncthreads();
    const int krs_ = min(max(rq - 4, 0), 56);
#define TV(j) ((MODE == 0) || (j) < 4 || ((unsigned)(a.kstart + (j) - 4 - krs_) < 8u))
#define PFILL(P0, P1) do { _Pragma("unroll") for (int _r = 0; _r < 16; ++_r) { P0[_r] = -1e30f; P1[_r] = -1e30f; } } while (0)
    bool vA = true, vB = true;
    qkt<DQK, QL>(pA0, pA1, K_lds, qr, r32, hi, Ql); AMOD(pA0, pA1, 0); partialSM<DQK>(pA0, pA1, m_reg, mnA, alA);
    SLOAD(SO, 1); if constexpr (SDEPTH == 2) { if (2 < NT) SLOAD(SE, 2); }
    SWAIT(); SWRITE(1, SO); __syncthreads();
#pragma unroll 1
    for (int j = 1; j + 1 < NT; j += 2) {
        vB = TV(j);
        SBAR(); if (vB) { qkt<DQK, QL>(pB0, pB1, K_lds + SHM_K, qr, r32, hi, Ql); AMOD(pB0, pB1, j); } else { PFILL(pB0, pB1); }
        finishSM(pA0, pA1, alA, l_reg, pa0, pa1, pa2, pa3); SBAR();
        SLOAD(SO, j + SDEPTH); SBAR();
        if (vA) pv_d0(o, vb0, pa0, pa1, pa2, pa3);
        partialSM<DQK>(pB0, pB1, m_reg, mnB, alB);
        __syncthreads(); SWAIT(); SWRITE(0, SE);
        RESC(alB); __syncthreads();
        vA = TV(j + 1);
        SBAR(); if (vA) { qkt<DQK, QL>(pA0, pA1, K_lds, qr, r32, hi, Ql); AMOD(pA0, pA1, j + 1); } else { PFILL(pA0, pA1); }
        finishSM(pB0, pB1, alB, l_reg, pa0, pa1, pa2, pa3); SBAR();
        if (SDEPTH == 1 || j + 3 < NT) SLOAD(SE, j + 1 + SDEPTH); SBAR();
        if (vB) pv_d0(o, vb0 + SHM_V, pa0, pa1, pa2, pa3);
        partialSM<DQK>(pA0, pA1, m_reg, mnA, alA);
        __syncthreads(); SWAIT(); SWRITE(1, SO);
        RESC(alA); __syncthreads();
    }
    vB = TV(NT - 1);
    SBAR(); if (vB) { qkt<DQK, QL>(pB0, pB1, K_lds + SHM_K, qr, r32, hi, Ql); AMOD(pB0, pB1, NT - 1); } else { PFILL(pB0, pB1); }
    finishSM(pA0, pA1, alA, l_reg, pa0, pa1, pa2, pa3); SBAR();
    if (vA) pv_d0(o, vb0, pa0, pa1, pa2, pa3);
    partialSM<DQK>(pB0, pB1, m_reg, mnB, alB);
    __syncthreads(); RESC(alB);
    finishSM(pB0, pB1, alB, l_reg, pa0, pa1, pa2, pa3); SBAR();
    if (vB) pv_d0(o, vb0 + SHM_V, pa0, pa1, pa2, pa3);
#undef TV
#undef PFILL
    if (hi == 0) li_l[r32] = l_reg; asm volatile("s_waitcnt lgkmcnt(0)" ::: "memory");
    float rli[16];
#pragma unroll
    for (int r = 0; r < 16; ++r) rli[r] = __builtin_amdgcn_rcpf(li_l[crow(r, hi)]);
    int tz = threadIdx.x; asm volatile("" : "+v"(tz));
    bf16_t* Ow = a.O + (size_t)(__builtin_amdgcn_readfirstlane(tz >> 6) * 32) * LDO + (tz & 31);
    const int hz = (tz >> 5) & 1;
#pragma unroll
    for (int r = 0; r < 16; ++r) { const int orow = crow(r, hz);
#pragma unroll
        for (int d0 = 0; d0 < 4; ++d0) Ow[(size_t)orow * LDO + d0 * 32] = f2bf(o[d0][r] * rli[r]); }
    __syncthreads();
#undef SLOAD
#undef SWRITE
#undef SWAIT
#undef RESC
#undef AMOD
}

template <int MODE, int LDQ, int LDK, int LDV, int LDO>
__device__ __forceinline__ void attn_body_dma(const AttnArgs& a, char* lds, const float* tab) {
    constexpr int DQK = 128, ND = 8, RING = 32768;
    int tid = threadIdx.x; asm volatile("" : "+v"(tid));
    const int wid = __builtin_amdgcn_readfirstlane(tid >> 6), lane = tid & 63, r32 = lane & 31, hi = lane >> 5;
    LAS unsigned char* ldsl = (LAS unsigned char*)lds + wid * 2048;
    float* wsf = (float*)(lds + LDS_EXCH) + wid * 64; float* li_l = wsf; float* al_l = wsf + 32;
    float m_reg = -1e30f, l_reg = 0; f32x16 o[4] = {}; bf16x8 qr[ND];
    { const char* Qw = (const char*)a.Q + (size_t)(wid * 32) * LDQ * 2; const unsigned qo = (unsigned)(r32 * LDQ + hi * 8) * 2u;
#pragma unroll
      for (int d0 = 0; d0 < ND; ++d0) qr[d0] = *reinterpret_cast<const bf16x8*>(Qw + qo + d0 * 32); }
    const int rq = a.rg * 4 + (wid >> 1), cq = (wid & 1) * 32 + r32;
    unsigned koff[2], voff[2];
#pragma unroll
    for (int i = 0; i < 2; ++i) { const int q = wid * 2 + i;
        { const int row = 4 * q + (lane >> 4), c = (lane & 15) ^ (kswz(row) >> 4); koff[i] = (unsigned)(row * LDK + c * 8) * 2u; }
        { const int blk = 2 * q + (lane >> 5), kk = (blk >> 2) * 8 + ((lane >> 2) & 7), k = (kk & ~0xC) | ((kk & 4) << 1) | ((kk & 8) >> 1), c = (blk & 3) * 32 + (lane & 3) * 8; voff[i] = (unsigned)(k * LDV + c) * 2u; } }
    const int vb0 = (int)(uintptr_t)lds + 16384 + v_rd_base(lane);
#define DMA(j, b) do { const int _t0 = tile_row<MODE>(a, (j)); const char* _kb = (const char*)a.K + (size_t)_t0 * (LDK * 2); const char* _vb = (const char*)a.V + (size_t)_t0 * (LDV * 2); \
    LAS unsigned char* _d = ldsl + (b) * RING; \
    __builtin_amdgcn_global_load_lds((const unsigned*)(_kb + koff[0]), (LAS unsigned*)(_d), 16, 0, 0); __builtin_amdgcn_global_load_lds((const unsigned*)(_kb + koff[1]), (LAS unsigned*)(_d + 1024), 16, 0, 0); \
    __builtin_amdgcn_global_load_lds((const unsigned*)(_vb + voff[0]), (LAS unsigned*)(_d + 16384), 16, 0, 0); __builtin_amdgcn_global_load_lds((const unsigned*)(_vb + voff[1]), (LAS unsigned*)(_d + 16384 + 1024), 16, 0, 0); } while (0)
#define TWAIT() do { asm volatile("s_waitcnt vmcnt(4)" ::: "memory"); __syncthreads(); } while (0)
#define RESC(al) do { if (__any((al) < 1.f)) { if (hi == 0) al_l[r32] = (al); asm volatile("s_waitcnt lgkmcnt(0)" ::: "memory"); \
    _Pragma("unroll") for (int d = 0; d < 4; ++d) _Pragma("unroll") for (int r = 0; r < 16; ++r) o[d][r] *= al_l[crow(r, hi)]; } } while (0)
#define AMOD(P0, P1, j) do { if (MODE == 1 && (j) >= 4) na_mod2(P0, P1, tabl + (a.kstart + (j) - 4 - rq + 7) * 31, okm); } while (0)
    const int krs_ = min(max(rq - 4, 0), 56);
    unsigned okm = 0; { const int cs = min(max(cq - 8, 0), 48);
#pragma unroll
      for (int r = 0; r < 16; ++r) { const int kc = crow(r, hi); okm |= ((unsigned)(kc - cs) < 16u ? 1u : 0u) << r; okm |= ((unsigned)(kc + 32 - cs) < 16u ? 1u : 0u) << (16 + r); } }
    const float* tabl = tab + 48 + 15 - cq + 4 * hi;
#define TV(j) ((MODE == 0) || (j) < 4 || ((unsigned)(a.kstart + (j) - 4 - krs_) < 8u))
#define PFILL(P0, P1) do { _Pragma("unroll") for (int _r = 0; _r < 16; ++_r) { P0[_r] = -1e30f; P1[_r] = -1e30f; } } while (0)
#define KB(j) (lds + ((j) & 3) * RING)
#define VB(j) (vb0 + ((j) & 3) * RING)
    f32x16 pA0, pA1, pB0, pB1; float mnA, mnB, alA, alB; bf16x8 pa0, pa1, pa2, pa3; const int NT = a.ntiles;
    bool vA = true, vB = true;
    asm volatile("s_waitcnt vmcnt(0)" ::: "memory");
    DMA(0, 0); DMA(1, 1);
    TWAIT(); DMA(2, 2);
    qkt<DQK, 0>(pA0, pA1, KB(0), qr, r32, hi, nullptr); AMOD(pA0, pA1, 0); partialSM<DQK>(pA0, pA1, m_reg, mnA, alA);
#pragma unroll 1
    for (int j = 1; j + 1 < NT; j += 2) {
        TWAIT(); DMA(min(j + 2, NT - 1), (j + 2) & 3);
        vB = TV(j);
        SBAR(); if (vB) { qkt<DQK, 0>(pB0, pB1, KB(j), qr, r32, hi, nullptr); AMOD(pB0, pB1, j); } else { PFILL(pB0, pB1); }
        finishSM(pA0, pA1, alA, l_reg, pa0, pa1, pa2, pa3); SBAR();
        if (vA) pv_d0(o, VB(j - 1), pa0, pa1, pa2, pa3);
        partialSM<DQK>(pB0, pB1, m_reg, mnB, alB);
        RESC(alB);
        TWAIT(); DMA(min(j + 3, NT - 1), (j + 3) & 3);
        vA = TV(j + 1);
        SBAR(); if (vA) { qkt<DQK, 0>(pA0, pA1, KB(j + 1), qr, r32, hi, nullptr); AMOD(pA0, pA1, j + 1); } else { PFILL(pA0, pA1); }
        finishSM(pB0, pB1, alB, l_reg, pa0, pa1, pa2, pa3); SBAR();
        if (vB) pv_d0(o, VB(j), pa0, pa1, pa2, pa3);
        partialSM<DQK>(pA0, pA1, m_reg, mnA, alA);
        RESC(alA);
    }
    asm volatile("s_waitcnt vmcnt(0)" ::: "memory"); __syncthreads();
    vB = TV(NT - 1);
    SBAR(); if (vB) { qkt<DQK, 0>(pB0, pB1, KB(NT - 1), qr, r32, hi, nullptr); AMOD(pB0, pB1, NT - 1); } else { PFILL(pB0, pB1); }
    finishSM(pA0, pA1, alA, l_reg, pa0, pa1, pa2, pa3); SBAR();
    if (vA) pv_d0(o, VB(NT - 2), pa0, pa1, pa2, pa3);
    partialSM<DQK>(pB0, pB1, m_reg, mnB, alB);
    RESC(alB);
    finishSM(pB0, pB1, alB, l_reg, pa0, pa1, pa2, pa3); SBAR();
    if (vB) pv_d0(o, VB(NT - 1), pa0, pa1, pa2, pa3);
#undef TV
#undef PFILL
#undef KB
#undef VB
#undef DMA
#undef TWAIT
#undef RESC
#undef AMOD
    if (hi == 0) li_l[r32] = l_reg; asm volatile("s_waitcnt lgkmcnt(0)" ::: "memory");
    float rli[16];
#pragma unroll
    for (int r = 0; r < 16; ++r) rli[r] = __builtin_amdgcn_rcpf(li_l[crow(r, hi)]);
    int tz = threadIdx.x; asm volatile("" : "+v"(tz));
    bf16_t* Ow = a.O + (size_t)(__builtin_amdgcn_readfirstlane(tz >> 6) * 32) * LDO + (tz & 31);
    const int hz = (tz >> 5) & 1;
#pragma unroll
    for (int r = 0; r < 16; ++r) { const int orow = crow(r, hz);
#pragma unroll
        for (int d0 = 0; d0 < 4; ++d0) Ow[(size_t)orow * LDO + d0 * 32] = f2bf(o[d0][r] * rli[r]); }
    asm volatile("s_waitcnt vmcnt(0)" ::: "memory");
    __syncthreads();
}

template <int DQK, int LDQ, int LDK, int LDV, int LDO>
__device__ __forceinline__ void attn_body_simple(const AttnArgs& a, char* lds) {
    constexpr int KCH = DQK / 64, KROWB = AttC<DQK>::KROWB, SHM_K = 64 * KROWB, SHM_V = 64 * 128 * 2, ND = DQK / 16, KC8 = DQK / 8;
    int tid = threadIdx.x; asm volatile("" : "+v"(tid));
    const int wid = __builtin_amdgcn_readfirstlane(tid >> 6), lane = tid & 63, r32 = lane & 31, hi = lane >> 5;
    char* V_lds = lds; char* K_lds = lds + 2 * SHM_V;
    float* wsf = (float*)(lds + 2 * SHM_V + 2 * SHM_K) + wid * 64; float* li_l = wsf; float* al_l = wsf + 32;
    float m_reg = -1e30f, l_reg = 0; f32x16 o[4] = {}; bf16x8 qr[ND];
    { const char* Qw = (const char*)a.Q + (size_t)(wid * 32) * LDQ * 2; const unsigned qo = (unsigned)(r32 * LDQ + hi * 8) * 2u;
#pragma unroll
      for (int d0 = 0; d0 < ND; ++d0) qr[d0] = *reinterpret_cast<const bf16x8*>(Qw + qo + d0 * 32); }
    const int sr = tid >> 4, sc = (tid & 15) * 8, vst0 = v_st(sr, sc), vst1 = v_st(32 + sr, sc);
    const unsigned voff = (unsigned)(sr * LDV + sc) * 2u;
    unsigned koff[KCH]; int kdst[KCH];
#pragma unroll
    for (int i = 0; i < KCH; ++i) { const int cid = tid + 512 * i; const int kr_ = cid / KC8, kc_ = (cid % KC8) * 8; koff[i] = (unsigned)(kr_ * LDK + kc_) * 2u; kdst[i] = kr_ * KROWB + ((kc_ * 2) ^ kswz(kr_)); }
    const int vb0 = (int)(uintptr_t)V_lds + v_rd_base(lane);
    bf16x8 vs0, vs1, ks[KCH];
#define SLOAD(j) do { const int _t0 = a.kbase + 64 * (j); const char* _vb = (const char*)a.V + (size_t)_t0 * (LDV * 2); const char* _kb = (const char*)a.K + (size_t)_t0 * (LDK * 2); \
    vs0 = *reinterpret_cast<const bf16x8*>(_vb + voff); vs1 = *reinterpret_cast<const bf16x8*>(_vb + voff + 32 * LDV * 2); \
    _Pragma("unroll") for (int _k = 0; _k < KCH; ++_k) ks[_k] = *reinterpret_cast<const bf16x8*>(_kb + koff[_k]); } while (0)
#define SWRITE(b) do { *(bf16x8*)(V_lds + (b) * SHM_V + vst0) = vs0; *(bf16x8*)(V_lds + (b) * SHM_V + vst1) = vs1; \
    _Pragma("unroll") for (int _k = 0; _k < KCH; ++_k) *(bf16x8*)(K_lds + (b) * SHM_K + kdst[_k]) = ks[_k]; } while (0)
    f32x16 p0, p1; float mn, al; bf16x8 pa0, pa1, pa2, pa3; const int NT = a.ntiles;
    SLOAD(0); asm volatile("s_waitcnt vmcnt(0)" ::: "memory"); SWRITE(0); __syncthreads();
#pragma unroll 1
    for (int j = 0; j < NT; ++j) {
        const int b = j & 1;
        if (j + 1 < NT) SLOAD(j + 1);
        SBAR(); qkt<DQK>(p0, p1, K_lds + b * SHM_K, qr, r32, hi);
        partialSM<DQK>(p0, p1, m_reg, mn, al);
        if (__any(al < 1.f)) { if (hi == 0) al_l[r32] = al; asm volatile("s_waitcnt lgkmcnt(0)" ::: "memory");
#pragma unroll
            for (int d = 0; d < 4; ++d)
#pragma unroll
                for (int r = 0; r < 16; ++r) o[d][r] *= al_l[crow(r, hi)]; }
        finishSM(p0, p1, al, l_reg, pa0, pa1, pa2, pa3); SBAR();
        pv_d0(o, vb0 + b * SHM_V, pa0, pa1, pa2, pa3);
        if (j + 1 < NT) { asm volatile("s_waitcnt vmcnt(0)" ::: "memory"); SWRITE(b ^ 1); }
        __syncthreads();
    }
    if (hi == 0) li_l[r32] = l_reg; asm volatile("s_waitcnt lgkmcnt(0)" ::: "memory");
    float rli[16];
#pragma unroll
    for (int r = 0; r < 16; ++r) rli[r] = __builtin_amdgcn_rcpf(li_l[crow(r, hi)]);
    int tz = threadIdx.x; asm volatile("" : "+v"(tz));
    bf16_t* Ow = a.O + (size_t)(__builtin_amdgcn_readfirstlane(tz >> 6) * 32) * LDO + (tz & 31);
    const int hz = (tz >> 5) & 1;
#pragma unroll
    for (int r = 0; r < 16; ++r) { const int orow = crow(r, hz);
#pragma unroll
        for (int d0 = 0; d0 < 4; ++d0) Ow[(size_t)orow * LDO + d0 * 32] = f2bf(o[d0][r] * rli[r]); }
    __syncthreads();
#undef SLOAD
#undef SWRITE
}

template <int DQK, int MODE, int LDQ, int LDK, int LDV, int LDO, int ABL = 0>
__device__ __forceinline__ void attn_body_stag(const AttnArgs& a, char* lds, const float* tab) {
    constexpr int KCH = DQK / 64, KROWB = AttC<DQK>::KROWB, SHM_K = 64 * KROWB, SHM_V = 64 * 128 * 2, ND = DQK / 16, KC8 = DQK / 8;
    int tid = threadIdx.x; asm volatile("" : "+v"(tid));
    const int wid = __builtin_amdgcn_readfirstlane(tid >> 6), lane = tid & 63, r32 = lane & 31, hi = lane >> 5;
    char* V_lds = lds; char* K_lds = lds + 2 * SHM_V;
    float* wsf = (float*)(lds + 2 * SHM_V + 2 * SHM_K) + wid * 64; float* li_l = wsf; float* al_l = wsf + 32;
    float m_reg = -1e30f, l_reg = 0; f32x16 o[4] = {}; bf16x8 qr[ND];
    { const char* Qw = (const char*)a.Q + (size_t)(wid * 32) * LDQ * 2; const unsigned qo = (unsigned)(r32 * LDQ + hi * 8) * 2u;
#pragma unroll
      for (int d0 = 0; d0 < ND; ++d0) qr[d0] = *reinterpret_cast<const bf16x8*>(Qw + qo + d0 * 32); }
    const int sr = tid >> 4, sc = (tid & 15) * 8, vst0 = v_st(sr, sc), vst1 = v_st(32 + sr, sc);
    const unsigned voff = (unsigned)(sr * LDV + sc) * 2u;
    unsigned koff[KCH]; int kdst[KCH];
#pragma unroll
    for (int i = 0; i < KCH; ++i) { const int cid = tid + 512 * i; const int kr_ = cid / KC8, kc_ = (cid % KC8) * 8; koff[i] = (unsigned)(kr_ * LDK + kc_) * 2u; kdst[i] = kr_ * KROWB + ((kc_ * 2) ^ kswz(kr_)); }
    const int vb0 = (int)(uintptr_t)V_lds + v_rd_base(lane);
    const int rq = a.rg * 4 + (wid >> 1), cq = (wid & 1) * 32 + r32; const int krs = min(max(rq - 4, 0), 56);
    bf16x8 vs0, vs1, ks[KCH];
#define SLOADK(j) do { const char* _kb = (const char*)a.K + (size_t)tile_row<MODE>(a, (j)) * (LDK * 2); \
    _Pragma("unroll") for (int _k = 0; _k < KCH; ++_k) ks[_k] = *reinterpret_cast<const bf16x8*>(_kb + koff[_k]); } while (0)
#define SLOADV(j) do { const char* _vb = (const char*)a.V + (size_t)tile_row<MODE>(a, (j)) * (LDV * 2); \
    vs0 = *reinterpret_cast<const bf16x8*>(_vb + voff); vs1 = *reinterpret_cast<const bf16x8*>(_vb + voff + 32 * LDV * 2); } while (0)
#define SWRITEK(b) do { _Pragma("unroll") for (int _k = 0; _k < KCH; ++_k) *(bf16x8*)(K_lds + (b) * SHM_K + kdst[_k]) = ks[_k]; } while (0)
#define SWRITEV(b) do { *(bf16x8*)(V_lds + (b) * SHM_V + vst0) = vs0; *(bf16x8*)(V_lds + (b) * SHM_V + vst1) = vs1; } while (0)
#define LBAR() do { asm volatile("s_waitcnt lgkmcnt(0)" ::: "memory"); __builtin_amdgcn_s_barrier(); asm volatile("" ::: "memory"); } while (0)
    f32x16 p0 = {}, p1 = {}; float mn, al = 1.f; bf16x8 pa0, pa1, pa2, pa3; const int NT = a.ntiles;
    SLOADK(0); SLOADV(0); asm volatile("s_waitcnt vmcnt(0)" ::: "memory"); SWRITEK(0); SWRITEV(0);
    SLOADK(1); SLOADV(1);
    LBAR();
    if (wid >= 4) LBAR();
#pragma unroll 1
    for (int j = 0; j < NT; ++j) {
        const int b = j & 1;
        const bool tv = (MODE == 0) || j < 4 || ((unsigned)(a.kstart + j - 4 - krs) < 8u);
        if (!(ABL & 8)) { if (j + 1 < NT) { SWRITEK(b ^ 1); if (j + 2 < NT) SLOADK(j + 2); } }
        SBAR();
        if (tv) { if (!(ABL & 1)) qkt_p<DQK>(p0, p1, K_lds + b * SHM_K, qr, r32, hi); else { asm volatile("" : "+v"(p0), "+v"(p1)); }
            if (MODE == 1) na_mod(p0, p1, j, a.kstart, rq, cq, tab, hi);
            if (!(ABL & 2)) { partialSM<DQK>(p0, p1, m_reg, mn, al); asm volatile("" : "+v"(p0), "+v"(p1), "+v"(al)); }
            else { al = 1.f; asm volatile("" : "+v"(p0), "+v"(p1)); } }
        SBAR();
        LBAR();
        if (!(ABL & 8)) { if (j + 1 < NT) { SWRITEV(b ^ 1); if (j + 2 < NT) SLOADV(j + 2); } }
        if (tv) {
        if (__any(al < 1.f)) { if (hi == 0) al_l[r32] = al; asm volatile("s_waitcnt lgkmcnt(0)" ::: "memory");
#pragma unroll
            for (int d = 0; d < 4; ++d)
#pragma unroll
                for (int r = 0; r < 16; ++r) o[d][r] *= al_l[crow(r, hi)]; }
        if (!(ABL & 2)) finishSM(p0, p1, al, l_reg, pa0, pa1, pa2, pa3); else { pa0 = *(bf16x8*)&p0; pa1 = *((bf16x8*)&p0 + 1); pa2 = *(bf16x8*)&p1; pa3 = *((bf16x8*)&p1 + 1); l_reg += 1.f; } SBAR();
        if (!(ABL & 4)) pv_il(o, vb0 + b * SHM_V, pa0, pa1, pa2, pa3); else { asm volatile("" :: "v"(pa0), "v"(pa1), "v"(pa2), "v"(pa3)); }
        }
        LBAR();
    }
    if (wid < 4) LBAR();
    if (hi == 0) li_l[r32] = l_reg; asm volatile("s_waitcnt lgkmcnt(0)" ::: "memory");
    float rli[16];
#pragma unroll
    for (int r = 0; r < 16; ++r) rli[r] = __builtin_amdgcn_rcpf(li_l[crow(r, hi)]);
    int tz = threadIdx.x; asm volatile("" : "+v"(tz));
    bf16_t* Ow = a.O + (size_t)(__builtin_amdgcn_readfirstlane(tz >> 6) * 32) * LDO + (tz & 31);
    const int hz = (tz >> 5) & 1;
#pragma unroll
    for (int r = 0; r < 16; ++r) { const int orow = crow(r, hz);
#pragma unroll
        for (int d0 = 0; d0 < 4; ++d0) Ow[(size_t)orow * LDO + d0 * 32] = f2bf(o[d0][r] * rli[r]); }
    __syncthreads();
#undef SLOADK
#undef SLOADV
#undef SWRITEK
#undef SWRITEV
#undef LBAR
}

struct Ctx { Params p; unsigned char* ws; char* lds; int G, bid; __device__ __forceinline__ LAS unsigned char* lds_las() const { return (LAS unsigned char*)lds; } };
#define PHASE_LANES() int tid = threadIdx.x; asm volatile("" : "+v"(tid)); const int lane = tid & 63; const int wid = __builtin_amdgcn_readfirstlane(tid >> 6); (void)lane; (void)wid; \
    int Pbid = X.bid, PG = X.G; asm volatile("" : "+s"(Pbid), "+s"(PG)); (void)Pbid; (void)PG;

__device__ __forceinline__ void phase_mod(const Ctx& X) {
    PHASE_LANES();
    float* sv = (float*)X.lds; float* red = (float*)(X.lds + 40960);
    for (int i = tid; i < 5 * 2048; i += NTHR) { const int r = i >> 11, k = i & 2047; const float c = r < 4 ? X.p.c[r * 2048 + k] : X.p.c_ctx[k]; sv[i] = silu_f(c); }
    __syncthreads();
    float* MOD = (float*)(X.ws + WS_MOD);
    for (int u = Pbid; u < DEPTH * 48; u += PG) {
        const int l = u / 48, cb = u % 48; const int cq = tid & 63, kg = tid >> 6;
        const float* W = X.p.w_mod + (size_t)l * 2048 * 12288 + cb * 256 + cq * 4;
        float acc[5][4];
#pragma unroll
        for (int r = 0; r < 5; ++r)
#pragma unroll
            for (int j = 0; j < 4; ++j) acc[r][j] = 0.f;
#pragma unroll 4
        for (int k = kg; k < 2048; k += 8) { const f32x4 w = *(const f32x4*)(W + (size_t)k * 12288);
#pragma unroll
            for (int r = 0; r < 5; ++r) { const float s = sv[r * 2048 + k];
#pragma unroll
                for (int j = 0; j < 4; ++j) acc[r][j] = fmaf(s, w[j], acc[r][j]); } }
#pragma unroll
        for (int r = 0; r < 5; ++r)
#pragma unroll
            for (int j = 0; j < 4; ++j) red[(kg * 5 + r) * 256 + cq * 4 + j] = acc[r][j];
        __syncthreads();
        for (int i = tid; i < 5 * 256; i += NTHR) { const int r = i >> 8, c = i & 255; float s = X.p.b_mod[l * 12288 + cb * 256 + c];
#pragma unroll
            for (int g = 0; g < 8; ++g) s += red[(g * 5 + r) * 256 + c];
            MOD[(size_t)(l * 5 + r) * 12288 + cb * 256 + c] = s; }
        __syncthreads();
    }
}
__device__ __forceinline__ void phase_rope(const Ctx& X) {
    PHASE_LANES();
    float* R = (float*)(X.ws + WS_ROPE);
    for (int i = Pbid * NTHR + tid; i < 4096 * 32; i += PG * NTHR) {
        const int pos = i >> 5, j = i & 31; const int fi = j & 15;
        const float invf = expf(-(float)fi * (1.f / 16.f) * 9.210340371976184f);
        const float ang = (float)(j < 16 ? (pos >> 6) : (pos & 63)) * invf;
        R[i] = __cosf(ang); R[4096 * 32 + i] = __sinf(ang);
    }
    float* SP = (float*)(X.ws + WS_SP8);
    for (int i = Pbid * NTHR + tid; i < DEPTH * 2 * 1024; i += PG * NTHR) {
        const float z = -X.p.lru_lam[i]; SP[i] = 8.f * (fmaxf(z, 0.f) + log1pf(expf(-fabsf(z))));
    }
}

template <int MAP> __device__ __forceinline__ int colmap(int n) {
    if (MAP == 0) return n;
    if (MAP == 1) {
        if (n < C_KR) return n;
        if (n < C_SG) { const int p = n - C_KR; if (p >= 64) return -1; return C_KR + ((p & 1) ? 32 + (p >> 1) : (p >> 1)); }
        return n - 192;
    }
    if (MAP == 3) { const int pn = n >> 8, w = n & 255; return w < 128 ? pn * 128 + w : DFF + pn * 128 + (w - 128); }
    { const int h = n / 192, j = n % 192; if (j < 128) return n; const int p = j - 128; return h * 192 + 128 + ((p & 1) ? 32 + (p >> 1) : (p >> 1)); }
}
template <int MAP, bool SWP = false>
__device__ __forceinline__ void prep_transpose(const Ctx& X, const float* src, int ldsrc, bf16_t* dst, int K, int Np, const float* kscale, const float* shv = nullptr, float* swp = nullptr) {
    PHASE_LANES();
    float* tile = (float*)X.lds;
    f32x4 shr[5][4]; int kt_c = -1;
    const int nkt = K / 128, nnt = Np / 64, nu = nkt * nnt;
    const int q4 = (tid & 15) * 4, kr = tid >> 4;
    f32x4 v[4], w[4];
#define PT_LOAD(u_, dstv) do { const int _k0 = ((u_) % nkt) * 128, _n0 = ((u_) / nkt) * 64; \
        const int s0 = colmap<MAP>(_n0 + q4), s1 = colmap<MAP>(_n0 + q4 + 1), s2 = colmap<MAP>(_n0 + q4 + 2), s3 = colmap<MAP>(_n0 + q4 + 3); \
        const bool vec = (s0 >= 0) && (s1 == s0 + 1) && (s2 == s0 + 2) && (s3 == s0 + 3) && ((s0 & 3) == 0); \
        if (vec) { _Pragma("unroll") for (int i = 0; i < 4; ++i) dstv[i] = *(const f32x4*)(src + (size_t)(_k0 + kr + 32 * i) * ldsrc + s0); } \
        else { _Pragma("unroll") for (int i = 0; i < 4; ++i) { const float* rp = src + (size_t)(_k0 + kr + 32 * i) * ldsrc; \
            dstv[i][0] = s0 >= 0 ? rp[s0] : 0.f; dstv[i][1] = s1 >= 0 ? rp[s1] : 0.f; dstv[i][2] = s2 >= 0 ? rp[s2] : 0.f; dstv[i][3] = s3 >= 0 ? rp[s3] : 0.f; } } } while (0)
    int u = Pbid; asm volatile("" : "+s"(u));
    if (u < nu) PT_LOAD(u, v);
    for (; u < nu; u += PG) {
        const int k0 = (u % nkt) * 128, n0 = (u / nkt) * 64;
        const bool more = u + PG < nu;
        if (more) PT_LOAD(u + PG, w);
        if (SWP) { if ((k0 >> 7) != kt_c) { kt_c = k0 >> 7;
#pragma unroll
            for (int mr = 0; mr < 5; ++mr)
#pragma unroll
                for (int j4 = 0; j4 < 4; ++j4) shr[mr][j4] = *(const f32x4*)(shv + (size_t)mr * 12288 + k0 + (tid & 7) * 16 + 4 * j4); } }
#pragma unroll
        for (int i = 0; i < 4; ++i) { const int kk = kr + 32 * i; const float sc = kscale ? kscale[k0 + kk] : 1.f;
            tile[kk * 65 + q4 + 0] = v[i][0] * sc; tile[kk * 65 + q4 + 1] = v[i][1] * sc; tile[kk * 65 + q4 + 2] = v[i][2] * sc; tile[kk * 65 + q4 + 3] = v[i][3] * sc; }
        __syncthreads();
        const int nn = tid >> 3, kc = (tid & 7) * 16;
        u32x4 w0, w1;
        float t[16];
#pragma unroll
        for (int j = 0; j < 16; ++j) t[j] = tile[(kc + j) * 65 + nn];
        w0.x = cvt_pk_bf16(t[0], t[1]); w0.y = cvt_pk_bf16(t[2], t[3]); w0.z = cvt_pk_bf16(t[4], t[5]); w0.w = cvt_pk_bf16(t[6], t[7]);
        w1.x = cvt_pk_bf16(t[8], t[9]); w1.y = cvt_pk_bf16(t[10], t[11]); w1.z = cvt_pk_bf16(t[12], t[13]); w1.w = cvt_pk_bf16(t[14], t[15]);
        if (SWP) {
#pragma unroll
            for (int mr = 0; mr < 5; ++mr) { float pp = 0.f;
#pragma unroll
                for (int j4 = 0; j4 < 4; ++j4) { const f32x4 sv = shr[mr][j4]; pp += t[4 * j4] * sv[0] + t[4 * j4 + 1] * sv[1] + t[4 * j4 + 2] * sv[2] + t[4 * j4 + 3] * sv[3]; }
                pp += __int_as_float(__builtin_amdgcn_mov_dpp(__float_as_int(pp), 0xB1, 0xf, 0xf, false));
                pp += __int_as_float(__builtin_amdgcn_mov_dpp(__float_as_int(pp), 0x4E, 0xf, 0xf, false));
                pp += __int_as_float(__builtin_amdgcn_mov_dpp(__float_as_int(pp), 0x141, 0xf, 0xf, false));
                if ((tid & 7) == 0) swp[((size_t)(k0 >> 7) * 5 + mr) * 12288 + n0 + nn] = pp; }
        }
        bf16_t* dp = dst + (size_t)(n0 + nn) * K + k0 + kc;
        *(u32x4*)dp = w0; *(u32x4*)(dp + 8) = w1;
        __syncthreads();
        if (more) {
#pragma unroll
            for (int i = 0; i < 4; ++i) v[i] = w[i]; }
    }
#undef PT_LOAD
}
__device__ __forceinline__ void prep_gates(const Ctx& X, int l, size_t wo) {
    PHASE_LANES();
    bf16_t* WG = (bf16_t*)(X.ws + WS_WGATE + wo);
    const int S = PG * NTHR;
    for (int i0 = Pbid * NTHR + tid; i0 < 4096 * 256 / 2; i0 += 4 * S) {
        float v0[4], v1[4];
#pragma unroll
        for (int q = 0; q < 4; ++q) { const int i = i0 + q * S; v0[q] = 0.f; v1[q] = 0.f;
            if (i < 4096 * 256 / 2) { const int e = i * 2; const int n = e >> 8, kk = e & 255;
                const int d = n >> 11, k = (n >> 8) & 7, g = (n >> 7) & 1, dout = n & 127;
                if ((kk >> 7) == (k & 1)) { const float* W = (g ? X.p.lru_w_x : X.p.lru_w_a) + ((size_t)((l * 2 + d) * 8 + k) * 128) * 128;
                    v0[q] = W[(size_t)(kk & 127) * 128 + dout]; v1[q] = W[(size_t)((kk + 1) & 127) * 128 + dout]; } } }
        asm volatile("" : "+v"(v0[0]), "+v"(v0[1]), "+v"(v0[2]), "+v"(v0[3]), "+v"(v1[0]), "+v"(v1[1]), "+v"(v1[2]), "+v"(v1[3]));
#pragma unroll
        for (int q = 0; q < 4; ++q) { const int i = i0 + q * S; if (i < 4096 * 256 / 2) *(unsigned*)(WG + i * 2) = cvt_pk_bf16(v0[q], v1[q]); }
    }
}
__device__ __forceinline__ void phase_prep(const Ctx& X, int l, int parts, size_t wo) {
    const Params& p = X.p;
    if (parts & 1) {
        prep_transpose<1, true>(X, p.w_in + (size_t)l * 2048 * DIN_SRC, DIN_SRC, (bf16_t*)(X.ws + WS_WIN + wo), 2048, DIN, nullptr, (const float*)(X.ws + WS_MOD) + (size_t)l * 5 * 12288, (float*)(X.ws + WS_SWP) + (size_t)((l & 1) * 2 + 0) * 16 * 5 * 12288);
        prep_transpose<3, true>(X, p.ffn_w_up + (size_t)l * 2048 * DFF2, DFF2, (bf16_t*)(X.ws + WS_WUP + wo), 2048, DFF2, nullptr, (const float*)(X.ws + WS_MOD) + (size_t)l * 5 * 12288 + 3 * 2048, (float*)(X.ws + WS_SWP) + (size_t)((l & 1) * 2 + 1) * 16 * 5 * 12288);
    }
    if (parts & 2) {
        prep_transpose<2>(X, p.mla_w_q_up + (size_t)l * 512 * 1536, 1536, (bf16_t*)(X.ws + WS_WQ + wo), 512, 1536, p.mla_q_norm + l * 512);
        prep_transpose<0>(X, p.mla_w_kv_up + (size_t)l * 256 * 2048, 2048, (bf16_t*)(X.ws + WS_WKV + wo), 256, 2048, p.mla_kv_norm + l * 256);
        prep_transpose<0>(X, p.w_branch + (size_t)l * 3 * 1024 * 2048, 2048, (bf16_t*)(X.ws + WS_WBR + wo), 3072, 2048, nullptr);
        prep_gates(X, l, wo);
    }
    if (parts & 4) {
        prep_transpose<0>(X, p.w_out + (size_t)l * 2048 * 2048, 2048, (bf16_t*)(X.ws + WS_WOUT + wo), 2048, 2048, nullptr);
        prep_transpose<0>(X, p.ffn_w_down + (size_t)l * DFF * 2048, 2048, (bf16_t*)(X.ws + WS_WDOWN + wo), DFF, 2048, nullptr);
    }
}

__device__ __forceinline__ void phase_norm(const Ctx& X, int l, const float* gain, int sh_chunk, int upd, int fold_goff, int src_mode, int nidx, int ctx_only, int w0 = 0) {
    PHASE_LANES();
    const float* MOD = (const float*)(X.ws + WS_MOD); bf16_t* H = (bf16_t*)(X.ws + WS_H); unsigned short* XS = (unsigned short*)(X.ws + WS_XS);
    const unsigned short* PART = (const unsigned short*)(X.ws + WS_PART); const unsigned short* DL = (const unsigned short*)(X.ws + WS_DELTA);
    const int nrows = ctx_only ? NB * CTXL : TT;
    if (Pbid < w0) return;
    for (int ri = (Pbid - w0) * 8 + wid; ri < nrows; ri += (PG - w0) * 8) {
        const int r = ctx_only ? (ri >> 8) * SEGT + (ri & 255) : ri;
        const int b = r / SEGT, rem = r % SEGT; const bool isctx = rem < CTXL; const int mr = isctx ? 4 : b;
        unsigned short* xr = XS + (size_t)r * 2048;
        f32x4 v[8]; float ss = 0.f;
        if (src_mode == 1) { const float* xs = isctx ? X.p.ctx + ((size_t)b * 256 + rem) * 2048 : X.p.x + ((size_t)b * 4096 + (rem - 256)) * 2048;
#pragma unroll
            for (int k = 0; k < 8; ++k) v[k] = *(const f32x4*)(xs + k * 256 + lane * 4);
        } else {
#pragma unroll
            for (int k = 0; k < 8; ++k) { const u32x2 w = *(const u32x2*)(xr + k * 256 + lane * 4); v[k] = (f32x4){h2lo(w.x), h2hi(w.x), h2lo(w.y), h2hi(w.y)}; }
        }
        if (upd) {
            if (isctx && fold_goff >= 0) {
                const float* gp = MOD + fold_goff + 4 * 12288;
                const unsigned short* pt = PART + ((size_t)(b * 8) * KSPLIT) * 65536 + (size_t)rem * 256 + lane * 4;
                f32x4 sum[8];
#pragma unroll
                for (int k = 0; k < 8; ++k) sum[k] = (f32x4){0.f, 0.f, 0.f, 0.f};
#pragma unroll 1
                for (int sl = 0; sl < KSPLIT; sl += 4) {
                    u32x2 wq[4][8];
#pragma unroll
                    for (int q = 0; q < 4; ++q)
#pragma unroll
                        for (int k = 0; k < 8; ++k) wq[q][k] = *(const u32x2*)(pt + (size_t)k * KSPLIT * 65536 + (size_t)q * 65536);
#pragma unroll
                    for (int q = 0; q < 4; ++q)
#pragma unroll
                        for (int k = 0; k < 8; ++k) { sum[k][0] += h2lo(wq[q][k].x); sum[k][1] += h2hi(wq[q][k].x); sum[k][2] += h2lo(wq[q][k].y); sum[k][3] += h2hi(wq[q][k].y); }
                    pt += 4 * 65536;
                }
#pragma unroll
                for (int k = 0; k < 8; ++k) v[k] += *(const f32x4*)(gp + k * 256 + lane * 4) * sum[k];
            } else if (!isctx) {
#pragma unroll
                for (int k = 0; k < 8; ++k) { const u32x2 dw = *(const u32x2*)(DL + (size_t)r * 2048 + k * 256 + lane * 4);
                    v[k][0] += h2lo(dw.x); v[k][1] += h2hi(dw.x); v[k][2] += h2lo(dw.y); v[k][3] += h2hi(dw.y); }
            }
        }
        if (upd || src_mode == 1) {
#pragma unroll
            for (int k = 0; k < 8; ++k) { u32x2 w; w.x = pack_h2(v[k][0], v[k][1]); w.y = pack_h2(v[k][2], v[k][3]); *(u32x2*)(xr + k * 256 + lane * 4) = w; }
        }
#pragma unroll
        for (int k = 0; k < 8; ++k) ss += v[k][0] * v[k][0] + v[k][1] * v[k][1] + v[k][2] * v[k][2] + v[k][3] * v[k][3];
        ss = wave_sum(ss);
        if (lane == 0) ((unsigned long long*)(X.ws + WS_SSQ))[(size_t)nidx * TT + r] = __float2ull_rn(ss * 16777216.f);
        const float* sh = MOD + (size_t)(l * 5 + mr) * 12288 + sh_chunk * 2048; const float* scp = sh + 2048;
        f32x4 gq[8], sq[8];
#pragma unroll
        for (int k = 0; k < 8; ++k) { gq[k] = *(const f32x4*)(gain + k * 256 + lane * 4); sq[k] = *(const f32x4*)(scp + k * 256 + lane * 4); }
        asm volatile("" ::: "memory");
#pragma unroll
        for (int k = 0; k < 8; ++k) { const int c = k * 256 + lane * 4;
            const f32x4 g = gq[k], s2 = sq[k];
            f32x4 y;
#pragma unroll
            for (int j = 0; j < 4; ++j) y[j] = v[k][j] * (g[j] * (1.f + s2[j]));
            u32x2 w; w.x = cvt_pk_bf16(y[0], y[1]); w.y = cvt_pk_bf16(y[2], y[3]);
            *(u32x2*)(H + (size_t)r * 2048 + c) = w; }
    }
}
__device__ __forceinline__ void phase_swreduce(const Ctx& X, int kind, int par) {
    PHASE_LANES();
    const float* P = (const float*)(X.ws + WS_SWP) + (size_t)(par * 2 + kind) * 16 * 5 * 12288; float* SW = (float*)(X.ws + WS_SW) + (size_t)kind * 5 * 12288;
    for (int i = Pbid * NTHR + tid; i < 5 * 12288; i += PG * NTHR) { float pv[16];
#pragma unroll
        for (int kt = 0; kt < 16; ++kt) pv[kt] = P[(size_t)kt * 5 * 12288 + i];
        asm volatile("" : "+v"(pv[0]), "+v"(pv[1]), "+v"(pv[2]), "+v"(pv[3]), "+v"(pv[4]), "+v"(pv[5]), "+v"(pv[6]), "+v"(pv[7]), "+v"(pv[8]), "+v"(pv[9]), "+v"(pv[10]), "+v"(pv[11]), "+v"(pv[12]), "+v"(pv[13]), "+v"(pv[14]), "+v"(pv[15]));
        float a = 0.f;
#pragma unroll
        for (int kt = 0; kt < 16; ++kt) a += pv[kt];
        SW[i] = a; }
}
__device__ __forceinline__ void phase_xinit(const Ctx& X) {
    PHASE_LANES();
    float* XS = (float*)(X.ws + WS_XS);
    for (int i = Pbid * NTHR + tid; i < TT * 512; i += PG * NTHR) {
        const int r = i >> 9, c = (i & 511) * 4; const int b = r / SEGT, rem = r % SEGT;
        const float* src = rem < CTXL ? X.p.ctx + ((size_t)b * 256 + rem) * 2048 : X.p.x + ((size_t)b * 4096 + (rem - 256)) * 2048;
        *(f32x4*)(XS + (size_t)r * 2048 + c) = *(const f32x4*)(src + c);
    }
}
__device__ __forceinline__ void phase_final(const Ctx& X) {
    PHASE_LANES();
    const unsigned short* XS = (const unsigned short*)(X.ws + WS_XS);
    f32x4 gfin[8];
#pragma unroll
    for (int k = 0; k < 8; ++k) gfin[k] = *(const f32x4*)(X.p.norm_final + k * 256 + lane * 4);
    for (int i0 = (Pbid * 8 + wid) * 2; i0 < NB * SEQ; i0 += PG * 8 * 2) {
        u32x2 xw[2][8];
#pragma unroll
        for (int q = 0; q < 2; ++q) { const int i = i0 + q; const int b = i / SEQ, s = i % SEQ; const size_t r = (size_t)b * SEGT + 256 + s;
#pragma unroll
            for (int k = 0; k < 8; ++k) xw[q][k] = *(const u32x2*)(XS + r * 2048 + k * 256 + lane * 4); }
#pragma unroll
        for (int q = 0; q < 2; ++q) { const int i = i0 + q;
            f32x4 v[8]; float ss = 0.f;
#pragma unroll
            for (int k = 0; k < 8; ++k) { v[k][0] = h2lo(xw[q][k].x); v[k][1] = h2hi(xw[q][k].x); v[k][2] = h2lo(xw[q][k].y); v[k][3] = h2hi(xw[q][k].y);
                ss += v[k][0] * v[k][0] + v[k][1] * v[k][1] + v[k][2] * v[k][2] + v[k][3] * v[k][3]; }
            ss = wave_sum(ss); const float rs = rsqrtf(ss * (1.f / 2048.f) + EPS);
#pragma unroll
            for (int k = 0; k < 8; ++k) { const int c = k * 256 + lane * 4; const f32x4 g = gfin[k];
                f32x4 y;
#pragma unroll
                for (int j = 0; j < 4; ++j) y[j] = v[k][j] * rs * g[j];
                *(f32x4*)(X.p.out + (size_t)i * 2048 + c) = y; }
        }
    }
}

__device__ __forceinline__ void phase_lruconv(const Ctx& X, int l) {
    PHASE_LANES();
    { const float* HLX = (const float*)(X.ws + WS_HLX); bf16_t* U = (bf16_t*)(X.ws + WS_U);
      const float* cw = X.p.lru_conv_w + (size_t)l * 4 * 1024; const float* cb = X.p.lru_conv_b + (size_t)l * 1024;
      for (int i = Pbid * NTHR + tid; i < NB * 15 * 3 * 256; i += PG * NTHR) {
          const int c = (i & 255) * 4; int q = i >> 8; const int which = q % 3; q /= 3; const int bi = q % 15, b = q / 15;
          const int pmU = b * PAN + 1 + bi, pmL = pmU + 1;
          const float* hU = HLX + (size_t)pmU * 6 * 1024 + c; const float* hL = HLX + (size_t)pmL * 6 * 1024 + c;
          const float *x0, *x1, *x2, *x3; size_t orow;
          if (which == 0) { x0 = hU + 3 * 1024; x1 = hU + 4 * 1024; x2 = hU + 5 * 1024; x3 = hL; orow = (size_t)pmU * 256 + 255; }
          else if (which == 1) { x0 = hU + 4 * 1024; x1 = hU + 5 * 1024; x2 = hL; x3 = hL + 1024; orow = (size_t)pmL * 256; }
          else { x0 = hU + 5 * 1024; x1 = hL; x2 = hL + 1024; x3 = hL + 2048; orow = (size_t)pmL * 256 + 1; }
          const f32x4 lb = *(const f32x4*)(cb + c), l0 = *(const f32x4*)(cw + c), l1 = *(const f32x4*)(cw + 1024 + c), l2 = *(const f32x4*)(cw + 2048 + c), l3 = *(const f32x4*)(cw + 3072 + c);
          const f32x4 y0 = *(const f32x4*)x0, y1 = *(const f32x4*)x1, y2 = *(const f32x4*)x2, y3 = *(const f32x4*)x3;
          asm volatile("" ::: "memory");
          const f32x4 uu = lb + l0 * y0 + l1 * y1 + l2 * y2 + l3 * y3;
          u32x2 w; w.x = cvt_pk_bf16(uu[0], uu[1]); w.y = cvt_pk_bf16(uu[2], uu[3]);
          *(u32x2*)(U + orow * 1024 + c) = w;
      } }
    const bf16_t* CQ = (const bf16_t*)(X.ws + WS_CQ); const bf16_t* CKV = (const bf16_t*)(X.ws + WS_CKV);
    float* RSQ = (float*)(X.ws + WS_RSQ); float* RSKV = (float*)(X.ws + WS_RSKV);
    for (int r4 = (Pbid * 8 + wid) * 4; r4 < TT; r4 += PG * 8 * 4) {
        u32x4 a[4]; u32x2 k[4];
#pragma unroll
        for (int q = 0; q < 4; ++q) { a[q] = *(const u32x4*)(CQ + (size_t)(r4 + q) * 512 + lane * 8); k[q] = *(const u32x2*)(CKV + (size_t)(r4 + q) * 256 + lane * 4); }
#pragma unroll
        for (int q = 0; q < 4; ++q) {
            float s = bflo(a[q].x) * bflo(a[q].x) + bfhi(a[q].x) * bfhi(a[q].x) + bflo(a[q].y) * bflo(a[q].y) + bfhi(a[q].y) * bfhi(a[q].y) + bflo(a[q].z) * bflo(a[q].z) + bfhi(a[q].z) * bfhi(a[q].z) + bflo(a[q].w) * bflo(a[q].w) + bfhi(a[q].w) * bfhi(a[q].w);
            float s2 = bflo(k[q].x) * bflo(k[q].x) + bfhi(k[q].x) * bfhi(k[q].x) + bflo(k[q].y) * bflo(k[q].y) + bfhi(k[q].y) * bfhi(k[q].y);
            s = wave_sum(s); s2 = wave_sum(s2);
            if (lane == 0) { RSQ[r4 + q] = rsqrtf(s * (1.f / 512.f) + EPS); RSKV[r4 + q] = rsqrtf(s2 * (1.f / 256.f) + EPS); }
        }
    }
}

__device__ __forceinline__ void phase_na(const Ctx& X, int l, bool with_ctx) {
    PHASE_LANES();
    const bf16_t* QKV = (const bf16_t*)(X.ws + WS_QKV); bf16_t* BR = (bf16_t*)(X.ws + WS_BR);
    float* tab = (float*)(X.lds + LDS_EXCH + 2048)    ;
    const int nlat = NB * 16 * 8, nctx = with_ctx ? NB * 8 : 0;
    for (int u = Pbid; u < nlat + nctx; u += PG) {
        if (u < nlat) {
            const int h = u & 7, rg = (u >> 3) & 15, b = u >> 7;
            for (int i = tid; i < NA_TABP; i += NTHR) { const int ix = i - 48; tab[i] = (unsigned)ix < 465u ? X.p.na_rpb[(size_t)(l * 8 + h) * 465 + ix] * 11.313708498984761f : 0.f; }
            AttnArgs a; const int base = b * SEGT;
            a.Q = QKV + (size_t)(base + 256 + rg * 256) * 3072 + h * 128; a.ldq = 3072;
            a.K = QKV + 1024 + h * 128; a.ldk = 3072; a.V = QKV + 2048 + h * 128; a.ldv = 3072;
            a.O = BR + (size_t)(base + 256 + rg * 256) * 3072 + h * 128; a.ldo = 3072;
            a.ntiles = 16; a.kbase = 0; a.ctxbase = base; a.latbase = base + 256; a.kstart = min(max(rg * 4 - 4, 0), 52); a.rg = rg;
            attn_body_dma<1, 3072, 3072, 3072, 3072>(a, X.lds, tab);
        } else {
            const int v = u - nlat; const int h = v & 7, b = v >> 3; const int base = b * SEGT;
            AttnArgs a;
            a.Q = QKV + (size_t)base * 3072 + h * 128; a.ldq = 3072;
            a.K = QKV + 1024 + h * 128; a.ldk = 3072; a.V = QKV + 2048 + h * 128; a.ldv = 3072;
            a.O = BR + (size_t)base * 3072 + h * 128; a.ldo = 3072;
            a.ntiles = 4; a.kbase = base; a.ctxbase = 0; a.latbase = 0; a.kstart = 0; a.rg = 0;
            attn_body_dma<0, 3072, 3072, 3072, 3072>(a, X.lds, tab);
        }
    }
}
template <int ABL> __device__ __forceinline__ void phase_mla(const Ctx& X, bool with_ctx) {
    PHASE_LANES();
    const bf16_t* QM = (const bf16_t*)(X.ws + WS_QM); const bf16_t* KM = (const bf16_t*)(X.ws + WS_KM); const bf16_t* VM = (const bf16_t*)(X.ws + WS_VM);
    bf16_t* BR = (bf16_t*)(X.ws + WS_BR) + 2048;
    const int nlat = NB * 16 * 8, nctx = with_ctx ? NB * 8 : 0;
    for (int u = Pbid; u < nlat + nctx; u += PG) {
        AttnArgs a; int h, base, q0;
        if (u < nlat) { h = u & 7; const int qb = (u >> 3) & 15, b = u >> 7; base = b * SEGT; q0 = base + 256 + qb * 256; a.ntiles = 68; }
        else { const int v = u - nlat; h = v & 7; base = (v >> 3) * SEGT; q0 = base; a.ntiles = 4; }
        a.Q = QM + (size_t)q0 * 1536 + h * 192; a.ldq = 1536; a.K = KM + h * 192; a.ldk = 1536; a.V = VM + h * 128; a.ldv = 1024;
        a.O = BR + (size_t)q0 * 3072 + h * 128; a.ldo = 3072; a.kbase = base; a.ctxbase = 0; a.latbase = 0; a.kstart = 0; a.rg = 0;
        if (ABL) a.O = (bf16_t*)(X.ws + WS_QKV) + (size_t)q0 * 3072 + h * 128;
#ifdef MLA_PIPE
        attn_body<192, 0, 1, 1536, 1536, 1024, 3072, 4>(a, X.lds, nullptr);
#else
        attn_body_stag<192, 0, 1536, 1536, 1024, 3072, ABL>(a, X.lds, nullptr);
#endif
    }
}

__device__ __forceinline__ void lru_ab(unsigned w, float spl2, float& a, float& b) { a = __builtin_amdgcn_exp2f(-(float)(w & 0xffffu) * spl2); b = __uint_as_float(w & 0xffff0000u); }
__device__ __forceinline__ void phase_scan1(const Ctx& X, int l) {
    PHASE_LANES();
    const unsigned* AB = (const unsigned*)(X.ws + WS_AB); const float* SP = (const float*)(X.ws + WS_SP8) + l * 2048;
    float* P = (float*)(X.ws + WS_PS); float* S = P + (size_t)NB * 2 * 68 * 1024;
    for (int i = Pbid * NTHR + tid; i < NB * 2 * 68 * 256 * 4; i += PG * NTHR) {
        const int seg = i & 3; const int c = ((i >> 2) & 255) * 4; const int ch = (i >> 10) % 68; const int bd = (i >> 10) / 68; const int d = bd & 1, b = bd >> 1;
        const size_t t0 = (size_t)b * SEGT + ch * 64;
        const unsigned* ap = AB + ((size_t)d * TT + t0) * 1024 + c;
        const f32x4 sl = *(const f32x4*)(SP + d * 1024 + c) * (1.4426950408889634f / 65535.f);
        f32x4 pp = {1.f, 1.f, 1.f, 1.f}, ss = {0.f, 0.f, 0.f, 0.f};
#pragma unroll
        for (int s = 0; s < 16; ++s) { const int q = seg * 16 + s; const int t = d ? 63 - q : q; const u32x4 w = *(const u32x4*)(ap + (size_t)t * 1024);
#pragma unroll
            for (int j = 0; j < 4; ++j) { float a, bb; lru_ab(w[j], sl[j], a, bb); pp[j] *= a; ss[j] = a * ss[j] + bb; } }
#pragma unroll
        for (int j = 0; j < 4; ++j) {
            float pe = __int_as_float(__builtin_amdgcn_update_dpp(0, __float_as_int(pp[j]), 0xA0  , 0xf, 0xf, false));
            float se = __int_as_float(__builtin_amdgcn_update_dpp(0, __float_as_int(ss[j]), 0xA0, 0xf, 0xf, false));
            if (seg & 1) { ss[j] = pp[j] * se + ss[j]; pp[j] = pp[j] * pe; }
            pe = __int_as_float(__builtin_amdgcn_update_dpp(0, __float_as_int(pp[j]), 0x55  , 0xf, 0xf, false));
            se = __int_as_float(__builtin_amdgcn_update_dpp(0, __float_as_int(ss[j]), 0x55, 0xf, 0xf, false));
            if (seg == 3) { ss[j] = pp[j] * se + ss[j]; pp[j] = pp[j] * pe; }
        }
        if (seg == 3) { *(f32x4*)(P + ((size_t)bd * 68 + ch) * 1024 + c) = pp; *(f32x4*)(S + ((size_t)bd * 68 + ch) * 1024 + c) = ss; }
    }
}
__device__ __forceinline__ void phase_scan2(const Ctx& X, int l) {
    PHASE_LANES();
    const unsigned* AB = (const unsigned*)(X.ws + WS_AB); const float* SP = (const float*)(X.ws + WS_SP8) + l * 2048;
    const float* P = (const float*)(X.ws + WS_PS); const float* S = P + (size_t)NB * 2 * 68 * 1024;
    const bf16_t* LG = (const bf16_t*)(X.ws + WS_LG); bf16_t* BR = (bf16_t*)(X.ws + WS_BR) + 1024;
    unsigned* slab = (unsigned*)X.lds;
    const int d = tid >> 8, ct = tid & 255;
    for (int u = (Pbid + 64) % PG; u < NB * 68 * 4; u += PG) {
        const int qt = u & 3, ch = (u >> 2) % 68, b = (u >> 2) / 68; const int c = qt * 256 + ct;
        const size_t t0 = (size_t)b * SEGT + ch * 64;
        u32x4 st[16], gl[4];
#pragma unroll
        for (int i = 0; i < 16; ++i) { const int e = tid + 512 * i; const int dd = e >> 12, row = (e >> 6) & 63, c4 = (e & 63) * 4;
            st[i] = *(const u32x4*)(AB + ((size_t)dd * TT + t0 + row) * 1024 + qt * 256 + c4); }
#pragma unroll
        for (int i = 0; i < 4; ++i) { const int e = tid + 512 * i; gl[i] = *(const u32x4*)(LG + (t0 + (e >> 5)) * 1024 + qt * 256 + (e & 31) * 8); }
        float h = 0.f;
        { const float* Pd = P + ((size_t)(b * 2 + d) * 68) * 1024 + c; const float* Sd = S + ((size_t)(b * 2 + d) * 68) * 1024 + c;
          const int cnt = d == 0 ? ch : (ch < 4 ? 3 - ch : 4 + 67 - ch);
          for (int k0 = 0; k0 < cnt; k0 += 8) {
              float pv[8], sv[8];
#pragma unroll
              for (int k = 0; k < 8; ++k) { int kk = k0 + k; kk = kk < cnt ? kk : cnt - 1; const int q = d == 0 ? kk : (kk < 4 ? 3 - kk : 71 - kk);
                  pv[k] = Pd[(size_t)q * 1024]; sv[k] = Sd[(size_t)q * 1024]; }
#pragma unroll
              for (int k = 0; k < 8; ++k) { const bool on = k0 + k < cnt; h = on ? pv[k] * h + sv[k] : h; }
          } }
#pragma unroll
        for (int i = 0; i < 16; ++i) { const int e = tid + 512 * i; *(u32x4*)(slab + (e >> 6) * 256 + (e & 63) * 4) = st[i]; }
        __syncthreads();
        { const float sl = SP[d * 1024 + c] * (1.4426950408889634f / 65535.f); unsigned* col = slab + d * 64 * 256 + ct;
          unsigned wv[8], wn[8];
#pragma unroll
          for (int k = 0; k < 8; ++k) wv[k] = col[(d ? 63 - k : k) * 256];
#pragma unroll 1
          for (int s0 = 0; s0 < 64; s0 += 8) {
#pragma unroll
              for (int k = 0; k < 8; ++k) { const int sn = (s0 + 8 + k) & 63; wn[k] = col[(d ? 63 - sn : sn) * 256]; }
              asm volatile("" : "+v"(wn[0]), "+v"(wn[1]), "+v"(wn[2]), "+v"(wn[3]), "+v"(wn[4]), "+v"(wn[5]), "+v"(wn[6]), "+v"(wn[7]));
              float hv[8];
#pragma unroll
              for (int k = 0; k < 8; ++k) { float a, bb; lru_ab(wv[k], sl, a, bb); h = a * h + bb; hv[k] = h; }
#pragma unroll
              for (int k = 0; k < 8; ++k) { const int sq = s0 + k; col[(d ? 63 - sq : sq) * 256] = __float_as_uint(hv[k]); }
#pragma unroll
              for (int k = 0; k < 8; ++k) wv[k] = wn[k];
          } }
        __syncthreads();
#pragma unroll
        for (int i = 0; i < 4; ++i) { const int e = tid + 512 * i; const int row = e >> 5, c8 = (e & 31) * 8;
            const f32x4 f0 = *(const f32x4*)(slab + row * 256 + c8), f1 = *(const f32x4*)(slab + row * 256 + c8 + 4);
            const f32x4 b0 = *(const f32x4*)(slab + (64 + row) * 256 + c8), b1 = *(const f32x4*)(slab + (64 + row) * 256 + c8 + 4);
            const f32x4 y0 = f0 + b0, y1 = f1 + b1;
            const u32x4 g = gl[i];
            u32x4 o; o.x = cvt_pk_bf16(bflo(g.x) * y0[0], bfhi(g.x) * y0[1]); o.y = cvt_pk_bf16(bflo(g.y) * y0[2], bfhi(g.y) * y0[3]);
            o.z = cvt_pk_bf16(bflo(g.z) * y1[0], bfhi(g.z) * y1[1]); o.w = cvt_pk_bf16(bflo(g.w) * y1[2], bfhi(g.w) * y1[3]);
            *(u32x4*)(BR + (t0 + row) * 3072 + qt * 256 + c8) = o; }
        __syncthreads();
    }
}

__device__ __forceinline__ void phase_ffnfix(const Ctx& X, int l) {
    PHASE_LANES();
    const float* HALO = (const float*)(X.ws + WS_HALO); bf16_t* ACT = (bf16_t*)(X.ws + WS_ACT);
    const float* cw = X.p.ffn_conv_w + (size_t)l * 3 * DFF2; const float* cb = X.p.ffn_conv_b + (size_t)l * DFF2;
    for (int i = Pbid * NTHR + tid; i < NB * 15 * 2 * (DFF / 4); i += PG * NTHR) {
        const int j = (i % (DFF / 4)) * 4; int q = i / (DFF / 4); const int which = q & 1; q >>= 1; const int bi = q % 15, b = q / 15;
        const int pmU = b * PAN + 1 + bi, pmL = pmU + 1;
        const float* hU = HALO + (size_t)pmU * 4 * DFF2; const float* hL = HALO + (size_t)pmL * 4 * DFF2;
        const float *rp, *rc, *rn; size_t orow;
        if (which == 0) { rp = hU + 2 * DFF2; rc = hU + 3 * DFF2; rn = hL; orow = (size_t)pmU * 256 + 255; }
        else { rp = hU + 3 * DFF2; rc = hL; rn = hL + DFF2; orow = (size_t)pmL * 256; }
        f32x4 uv = *(const f32x4*)(cb + j), ug = *(const f32x4*)(cb + DFF + j);
        uv += *(const f32x4*)(cw + j) * *(const f32x4*)(rp + j) + *(const f32x4*)(cw + DFF2 + j) * *(const f32x4*)(rc + j) + *(const f32x4*)(cw + 2 * DFF2 + j) * *(const f32x4*)(rn + j);
        ug += *(const f32x4*)(cw + DFF + j) * *(const f32x4*)(rp + DFF + j) + *(const f32x4*)(cw + DFF2 + DFF + j) * *(const f32x4*)(rc + DFF + j) + *(const f32x4*)(cw + 2 * DFF2 + DFF + j) * *(const f32x4*)(rn + DFF + j);
        u32x2 w; w.x = cvt_pk_bf16(silu_f(ug[0]) * uv[0], silu_f(ug[1]) * uv[1]); w.y = cvt_pk_bf16(silu_f(ug[2]) * uv[2], silu_f(ug[3]) * uv[3]);
        *(u32x2*)(ACT + orow * DFF + j) = w;
    }
}

template <class Epi>
__device__ __forceinline__ void run_gemm(const Ctx& X, const bf16_t* A, int lda, const bf16_t* Bt, int ldb, int N, int K, const Epi& E, int omode = 0, int amask = 0, int ashift = 0, int astep = 0) {
    int Gq = X.G, Bq = X.bid; asm volatile("" : "+s"(Gq), "+s"(Bq));
    int Kv = K; asm volatile("" : "+s"(Kv));
    pg8::Gemm g{A, lda, Bt, ldb, TT, N, Kv, amask, ashift, astep}; pg8::Order S; S.init(N, Kv, Gq, Bq, omode, KSPLIT);
    __syncthreads();
    pg8::gemm_phase<Epi>((LAS unsigned char*)X.lds, g, S, E);
}

constexpr int PH_PER_LAYER = 12;
constexpr int N_PHASES = 1 + DEPTH * PH_PER_LAYER + 1;

__global__ void __launch_bounds__(NTHR, 2) fwd_kernel(Params p) {
    extern __shared__ __attribute__((aligned(16))) unsigned char lds_raw[];
    Ctx X; X.p = p; X.ws = p.ws; X.lds = (char*)lds_raw; X.G = gridDim.x; X.bid = blockIdx.x;
    const int lo = p.ph_lo, hi = p.ph_hi;
    volatile LAS unsigned* barw = (volatile LAS unsigned*)(lds_raw + LDS_BARW);
    if (threadIdx.x < 4) barw[threadIdx.x] = 0u;
    __syncthreads();
    XcdBarrier bar; bar.bar = (unsigned*)(p.ws + WS_BAR); bar.x = 0; bar.st = barw;
    if (hi - lo > 1) bar = xcd_barrier_post((unsigned*)(p.ws + WS_BAR), barw);
#ifndef PHMASK
#define PHMASK 0xFFFF
#endif
#define IN(k) (lo <= (k) && (k) < hi)
#define EN(i) ((PHMASK >> (i)) & 1)
#ifndef DUPMASK
#define DUPMASK 0
#endif
#ifndef DUPN
#define DUPN 1
#endif
#define REPS(i) (((DUPMASK >> (i)) & 1) ? 1 + DUPN : 1)
#ifdef EXTRA_BAR
#define SEAM(k) do { if (IN(k) && IN((k) + 1)) { xcd_barrier(bar); xcd_barrier(bar); } } while (0)
#else
#define SEAM(k) do { if (IN(k) && IN((k) + 1)) xcd_barrier(bar); } while (0)
#endif
    unsigned char* ws = p.ws;
    const float* rope = (const float*)(ws + WS_ROPE);

    if (EN(12) && IN(0)) { phase_mod(X); phase_rope(X);
        { unsigned long long* SQ = (unsigned long long*)(ws + WS_SSQ); for (int i = X.bid * NTHR + threadIdx.x; i < 8 * TT; i += X.G * NTHR) __hip_atomic_store(SQ + i, 0ull, __ATOMIC_RELAXED, __HIP_MEMORY_SCOPE_AGENT); } }
    SEAM(0);
    for (int l = 0; l < DEPTH; ++l) {
        const int pb = 1 + l * PH_PER_LAYER; const bool lastl = (l == DEPTH - 1);
        const size_t wo = (size_t)(l & 1) * WSET_BYTES; int Gv_ = X.G; asm volatile("" : "+s"(Gv_)); const bool early = (Gv_ == 256);
        const bool mg0 = (l > 0) && early && (hi - lo > 1);
        if (EN(0) && IN(pb + 0)) _Pragma("unroll 1") for (int rep = 0; rep < REPS(0); ++rep) { if (l == 0 || !early) { phase_prep(X, l, 1, wo); if (hi - lo > 1) xcd_barrier(bar); }
            const bool tp0 = (l == 0) && early && (hi - lo > 1);
            if (!mg0) phase_prep(X, l, tp0 ? 4 : 6, wo);
            phase_norm(X, l, p.norm_mix + l * 2048, 0, (l > 0 && rep == 0) ? 1 : 0, l > 0 ? (l - 1) * 5 * 12288 + 5 * 2048 : -1, l == 0 ? 1 : 0, 2 * l, l > 0 ? 1 : 0);
            if (!mg0) phase_swreduce(X, 0, l & 1); else split_arrive((unsigned*)(ws + WS_BAR), 2 * l); }
        if (!mg0) SEAM(pb + 0);
        if (EN(1) && IN(pb + 1)) _Pragma("unroll 1") for (int rep = 0; rep < REPS(1); ++rep) { EpiInProj E{ws, rope, p.lru_conv_w + (size_t)l * 4 * 1024, p.lru_conv_b + (size_t)l * 1024, X.lds, RowScale{ws + WS_SSQ + (size_t)(2 * l) * TT * 8, (const float*)(ws + WS_SW), (unsigned*)(ws + WS_BAR), mg0 ? 2 * l : -1, (unsigned)X.G}}; run_gemm(X, (const bf16_t*)(ws + WS_H), 2048, (const bf16_t*)(ws + WS_WIN + wo), 2048, DIN, 2048, E, mg0 ? 3 : 0);
            if ((mg0 || ((l == 0) && early && (hi - lo > 1))) && X.bid >= 192) { Ctx Y = X; Y.bid = X.bid - 192; Y.G = X.G - 192; phase_prep(Y, l, 2, wo); } }
        SEAM(pb + 1);
        if (EN(2) && IN(pb + 2)) _Pragma("unroll 1") for (int rep = 0; rep < REPS(2); ++rep) { phase_lruconv(X, l); if (hi - lo > 1) split_arrive((unsigned*)(ws + WS_BAR), 8 + l); else __syncthreads(); phase_na(X, l, !lastl); }
        if (!(hi - lo > 1)) SEAM(pb + 2);
        if (EN(3) && IN(pb + 3)) _Pragma("unroll 1") for (int rep = 0; rep < REPS(3); ++rep) {
            if (hi - lo > 1) { split_wait((unsigned*)(ws + WS_BAR), 8 + l, (unsigned)X.G); __syncthreads(); }
#ifndef PH3SUB
#define PH3SUB 7
#endif
#ifdef NO_GROUP3
            if (PH3SUB & 1) { EpiGates E{ws, p.lru_b_a + l * 2048, p.lru_b_x + l * 2048, (const float*)(ws + WS_SP8) + l * 2048};
              run_gemm(X, (const bf16_t*)(ws + WS_U), 1024, (const bf16_t*)(ws + WS_WGATE + wo), 256, 4096, 256, E, 0, 7, 1, 256); }
            if (PH3SUB & 2) { EpiQup E{ws, rope}; run_gemm(X, (const bf16_t*)(ws + WS_CQ), 512, (const bf16_t*)(ws + WS_WQ + wo), 512, 1536, 512, E); }
            if (PH3SUB & 4) { EpiKVup E{ws}; run_gemm(X, (const bf16_t*)(ws + WS_CKV), 256, (const bf16_t*)(ws + WS_WKV + wo), 256, 2048, 256, E); }
#else
            {
                EpiGates Eg{ws, p.lru_b_a + l * 2048, p.lru_b_x + l * 2048, (const float*)(ws + WS_SP8) + l * 2048}; EpiQup Eq{ws, rope}; EpiKVup Ek{ws};
                int Gq = X.G, Bq = X.bid, k4 = 4, k8 = 8; asm volatile("" : "+s"(Gq), "+s"(Bq), "+s"(k4), "+s"(k8));
                pg8::G3 g0{(const bf16_t*)(ws + WS_U), (const bf16_t*)(ws + WS_WGATE + wo), 1024, 256, 16, k4, 7, 1, 256};
                pg8::G3 g1{(const bf16_t*)(ws + WS_CQ), (const bf16_t*)(ws + WS_WQ + wo), 512, 512, 6, k8, 0, 0, 0};
                pg8::G3 g2{(const bf16_t*)(ws + WS_CKV), (const bf16_t*)(ws + WS_WKV + wo), 256, 256, 8, k4, 0, 0, 0};
                __syncthreads();
                pg8::gemm_phase3(X.lds_las(), g0, g1, g2, Gq, Bq, Eg, Eq, Ek);
            }
#endif
        }
        SEAM(pb + 3);
        if (EN(4) && IN(pb + 4)) _Pragma("unroll 1") for (int rep = 0; rep < REPS(4); ++rep) {
#if defined(PROBE_SKIP)
            if (rep == 0) { phase_mla<0>(X, !lastl); __syncthreads(); phase_scan2(X, l); } else phase_mla<PROBE_SKIP>(X, !lastl);
#else
            phase_mla<0>(X, !lastl); __syncthreads(); phase_scan2(X, l);
#endif
        }
        SEAM(pb + 4);
        if (EN(6) && IN(pb + 6)) _Pragma("unroll 1") for (int rep = 0; rep < REPS(6); ++rep) {
            { EpiMergeF E{ws}; run_gemm(X, (const bf16_t*)(ws + WS_BR), 3072, (const bf16_t*)(ws + WS_WBR + wo), 3072, 2048, 3072, E, lastl ? 1 : 0); }
            if (early && !lastl && X.bid >= 32) { Ctx Y = X; Y.bid = X.bid - 32; Y.G = X.G - 32; if (hi - lo > 1) phase_swreduce(Y, 1, l & 1); phase_prep(Y, l + 1, 1, (size_t)((l + 1) & 1) * WSET_BYTES); }
        }
        SEAM(pb + 6);
        if (EN(7) && IN(pb + 7)) _Pragma("unroll 1") for (int rep = 0; rep < REPS(7); ++rep) { if ((hi - lo > 1) && !(early && !lastl)) phase_swreduce(X, 1, l & 1); EpiResid E{ws, l * 5 * 12288 + 2 * 2048, p.norm_ffn + l * 2048, l * 5 * 12288 + 4 * 2048, 2 * l + 1}; run_gemm(X, (const bf16_t*)(ws + WS_YMB), 2048, (const bf16_t*)(ws + WS_WOUT + wo), 2048, 2048, 2048, E, lastl ? 1 : 2); }
        SEAM(pb + 7);
        if (EN(8) && IN(pb + 8)) _Pragma("unroll 1") for (int rep = 0; rep < REPS(8); ++rep) { if (!lastl) phase_norm(X, l, p.norm_ffn + l * 2048, 3, rep == 0 ? 1 : 0, l * 5 * 12288 + 2 * 2048, (l == 0 && rep == 0) ? 1 : 0, 2 * l + 1, 1); if (hi - lo > 1) { if (!lastl) split_arrive((unsigned*)(ws + WS_BAR), 2 * l + 1); } else phase_swreduce(X, 1, l & 1); }
        if (!(hi - lo > 1)) SEAM(pb + 8);
        if (EN(9) && IN(pb + 9)) _Pragma("unroll 1") for (int rep = 0; rep < REPS(9); ++rep) { EpiFfnUp E{ws, p.ffn_conv_w + (size_t)l * 3 * DFF2, p.ffn_conv_b + (size_t)l * DFF2, X.lds, RowScale{ws + WS_SSQ + (size_t)(2 * l + 1) * TT * 8, (const float*)(ws + WS_SW) + 5 * 12288, (unsigned*)(ws + WS_BAR), (!lastl && hi - lo > 1) ? 2 * l + 1 : -1, (unsigned)X.G}}; run_gemm(X, (const bf16_t*)(ws + WS_H), 2048, (const bf16_t*)(ws + WS_WUP + wo), 2048, DFF2, 2048, E, lastl ? 1 : ((hi - lo > 1) ? 3 : 0));
            if (!lastl && early && (hi - lo > 1) && X.bid >= 176) { Ctx Y = X; Y.bid = X.bid - 176; Y.G = X.G - 176; phase_swreduce(Y, 0, (l + 1) & 1); phase_prep(Y, l + 1, 4, (size_t)((l + 1) & 1) * WSET_BYTES); } }
        SEAM(pb + 9);
        if (EN(10) && IN(pb + 10)) _Pragma("unroll 1") for (int rep = 0; rep < REPS(10); ++rep) { phase_ffnfix(X, l); }
        SEAM(pb + 10);
        if (EN(11) && IN(pb + 11)) _Pragma("unroll 1") for (int rep = 0; rep < REPS(11); ++rep) { EpiResid E{ws, l * 5 * 12288 + 5 * 2048, lastl ? (const float*)nullptr : p.norm_mix + (l + 1) * 2048, (l + 1) * 5 * 12288 + 1 * 2048, 2 * (l + 1)}; run_gemm(X, (const bf16_t*)(ws + WS_ACT), DFF, (const bf16_t*)(ws + WS_WDOWN + wo), DFF, 2048, DFF, E, lastl ? 1 : 2); }
        SEAM(pb + 11);
    }
    if (EN(13) && IN(N_PHASES - 1)) phase_final(X);
#undef IN
#undef SEAM
}

extern "C" void kernel_launch(void* const* d_in, const int* in_sizes, int n_in, void* d_out, int out_size, void* d_ws, size_t ws_size, hipStream_t stream) {
    static int grid = 0;
    if (grid == 0) {
        if (n_in != 28 || ws_size < WS_END) { fprintf(stderr, "kernel_launch: need 28 inputs and >= %zu bytes of workspace; got %d, %zu\n", (size_t)WS_END, n_in, ws_size); grid = -1; return; }
        int dev = 0, cus = 0, per_cu = 0;
        if (hipGetDevice(&dev) != hipSuccess || hipDeviceGetAttribute(&cus, hipDeviceAttributeMultiprocessorCount, dev) != hipSuccess) { grid = -1; return; }
        if (hipFuncSetAttribute((const void*)fwd_kernel, hipFuncAttributeMaxDynamicSharedMemorySize, LDS_BYTES) != hipSuccess) { fprintf(stderr, "kernel_launch: hipFuncSetAttribute failed\n"); grid = -1; return; }
        if (hipOccupancyMaxActiveBlocksPerMultiprocessor(&per_cu, (const void*)fwd_kernel, NTHR, LDS_BYTES) != hipSuccess || per_cu < 1) { fprintf(stderr, "kernel_launch: occupancy query says %d\n", per_cu); }
        (void)hipGetLastError();
        grid = cus;
    }
    if (grid < 0) return;
    (void)hipMemsetAsync((char*)d_ws + WS_BAR, 0, 16384, stream);
    Params p{};
    const float** pin = (const float**)&p;
    for (int i = 0; i < 28; ++i) pin[i] = (const float*)d_in[i];
    p.out = (float*)d_out; p.ws = (unsigned char*)d_ws;
#if MK_SINGLE
    p.ph_lo = 0; p.ph_hi = N_PHASES;
    hipLaunchKernelGGL(fwd_kernel, dim3(grid), dim3(NTHR), LDS_BYTES, stream, p);
#else
    for (int k = 0; k < N_PHASES; ++k) { p.ph_lo = k; p.ph_hi = k + 1; hipLaunchKernelGGL(fwd_kernel, dim3(grid), dim3(NTHR), LDS_BYTES, stream, p); }
#endif
    const hipError_t le = hipPeekAtLastError();
    if (le != hipSuccess) fprintf(stderr, "kernel_launch: launch failed: %s\n", hipGetErrorName(le));
}
```
